# Optimizing an MI355X kernel written in HIP

```python
import math
import jax, jax.numpy as jnp
from jax import lax
import numpy as np

D_MODEL = 1024
BATCH = 4
SEQ = 8192
DEPTH = 2

GRID_W = 64
CTX_LEN = 256
N_MIXERS = 2
MIXER_MLA = 0
MIXER_CONV = 1
N_HEADS = 8
QK_NOPE = 128
QK_ROPE = 64
V_HEAD = 128
Q_LORA = 256
KV_LORA = 128
CONV_W = 3
D_FF = ((8 * D_MODEL + 3 * 256 - 1) // (3 * 256)) * 256
ROPE_THETA = 10000.0
NORM_EPS = 1e-6
Q_BLOCK = 128
ATTN_SCALE = 1.0 / math.sqrt(QK_NOPE + QK_ROPE)
N_MLA_LAYERS = (DEPTH + N_MIXERS - 1) // N_MIXERS
N_CONV_LAYERS = DEPTH // N_MIXERS

kernel_name = "hybrid_mla_shortconv_dit_block"


def rmsnorm(x, w):
    xf = x.astype(jnp.float32)
    y = xf * lax.rsqrt(jnp.mean(xf * xf, axis=-1, keepdims=True) + NORM_EPS)
    return (y * w.astype(jnp.float32)).astype(x.dtype)


def modulate(h, shift, scale):
    return h * (1 + scale) + shift


def axial_angles(n_tok):
    rows = n_tok // GRID_W
    row, col = jnp.meshgrid(jnp.arange(rows), jnp.arange(GRID_W), indexing="ij")
    row = row.reshape(-1).astype(jnp.float32)
    col = col.reshape(-1).astype(jnp.float32)
    n_freq = QK_ROPE // 4
    freqs = ROPE_THETA ** (-jnp.arange(n_freq, dtype=jnp.float32) / n_freq)
    return row[:, None] * freqs, col[:, None] * freqs


def rotate_half(x, ang):
    x1, x2 = jnp.split(x, 2, axis=-1)
    cos, sin = jnp.cos(ang), jnp.sin(ang)
    return jnp.concatenate([x1 * cos - x2 * sin, x2 * cos + x1 * sin], axis=-1)


def axial_rope(x, ang_row, ang_col):
    extra = x.ndim - 3
    shp = (ang_row.shape[0],) + (1,) * extra + (ang_row.shape[1],)
    xr, xc = jnp.split(x.astype(jnp.float32), 2, axis=-1)
    out = jnp.concatenate([rotate_half(xr, ang_row.reshape(shp)),
                           rotate_half(xc, ang_col.reshape(shp))], axis=-1)
    return out.astype(x.dtype)


def mla_qkv(h, w_dq, q_norm, w_uq, w_dkv, kv_norm, w_ukv):
    b, n, _ = h.shape
    q = (rmsnorm(h @ w_dq, q_norm) @ w_uq).reshape(b, n, N_HEADS, QK_NOPE + QK_ROPE)
    kv_a = h @ w_dkv
    kv = (rmsnorm(kv_a[..., :KV_LORA], kv_norm) @ w_ukv).reshape(b, n, N_HEADS, QK_NOPE + V_HEAD)
    return (q[..., :QK_NOPE], q[..., QK_NOPE:],
            kv[..., :QK_NOPE], kv_a[..., KV_LORA:], kv[..., QK_NOPE:])


def attend(q_nope, q_rope, k_nope, k_rope, v):
    s = (jnp.einsum("bqhd,bkhd->bhqk", q_nope, k_nope)
         + jnp.einsum("bqhr,bkr->bhqk", q_rope, k_rope))
    p = jax.nn.softmax(s.astype(jnp.float32) * ATTN_SCALE, axis=-1).astype(v.dtype)
    return jnp.einsum("bhqk,bkhd->bqhd", p, v)


def mla_mixer(h_lat, h_ctx, w_dq, q_norm, w_uq, w_dkv, kv_norm, w_ukv, w_o,
              ang_row, ang_col, with_ctx_out):
    b, n, _ = h_lat.shape
    qn_l, qr_l, kn_l, kr_l, v_l = mla_qkv(h_lat, w_dq, q_norm, w_uq, w_dkv, kv_norm, w_ukv)
    qr_l = axial_rope(qr_l, ang_row, ang_col)
    kr_l = axial_rope(kr_l, ang_row, ang_col)
    qn_c, qr_c, kn_c, kr_c, v_c = mla_qkv(h_ctx, w_dq, q_norm, w_uq, w_dkv, kv_norm, w_ukv)
    k_nope = jnp.concatenate([kn_c, kn_l], axis=1)
    k_rope = jnp.concatenate([kr_c, kr_l], axis=1)
    v = jnp.concatenate([v_c, v_l], axis=1)
    nb = n // Q_BLOCK

    def to_blocks(t):
        return jnp.moveaxis(t.reshape(b, nb, Q_BLOCK, *t.shape[2:]), 1, 0)

    o = lax.map(lambda q: attend(q[0], q[1], k_nope, k_rope, v), (to_blocks(qn_l), to_blocks(qr_l)))
    o = jnp.moveaxis(o, 0, 1).reshape(b, n, N_HEADS * V_HEAD)
    y_lat = o @ w_o
    y_ctx = None
    if with_ctx_out:
        o_c = attend(qn_c, qr_c, kn_c, kr_c, v_c)
        y_ctx = o_c.reshape(b, h_ctx.shape[1], N_HEADS * V_HEAD) @ w_o
    return y_lat, y_ctx


def short_conv(h, w_in, w_conv, w_out):
    b_g, c_g, xv = jnp.split(h @ w_in, 3, axis=-1)
    u = lax.conv_general_dilated(c_g * xv, w_conv[:, None, :], window_strides=(1,),
                                 padding=[(CONV_W // 2, CONV_W // 2)],
                                 dimension_numbers=("NWC", "WIO", "NWC"),
                                 feature_group_count=D_MODEL)
    return (b_g * u) @ w_out


def swiglu(h, w_gate, w_up, w_down):
    return (jax.nn.silu(h @ w_gate) * (h @ w_up)) @ w_down


def setup_inputs(seed: int = 0) -> dict:
    key = jax.random.key(seed)
    ks = jax.random.split(key, 24)
    f32 = jnp.float32

    def nrm(k, shape, scale):
        return jax.random.normal(k, shape, f32) * scale

    def gain(k, shape):
        return 1.0 + 0.02 * jax.random.normal(k, shape, f32)

    d = D_MODEL
    return {
        "x": nrm(ks[0], (BATCH, SEQ, d), 1.0),
        "c": nrm(ks[1], (BATCH, d), 1.0),
        "ctx": nrm(ks[2], (BATCH, CTX_LEN, d), 1.0),
        "c_ctx": nrm(ks[3], (d,), 1.0),
        "ada_w": nrm(ks[4], (DEPTH, d, 6 * d), 0.5 * d ** -0.5),
        "ada_b": nrm(ks[5], (DEPTH, 6 * d), 0.02),
        "norm_mix": gain(ks[6], (DEPTH, d)),
        "norm_ffn": gain(ks[7], (DEPTH, d)),
        "mla_w_dq": nrm(ks[8], (N_MLA_LAYERS, d, Q_LORA), d ** -0.5),
        "mla_q_norm": gain(ks[9], (N_MLA_LAYERS, Q_LORA)),
        "mla_w_uq": nrm(ks[10], (N_MLA_LAYERS, Q_LORA, N_HEADS * (QK_NOPE + QK_ROPE)), Q_LORA ** -0.5),
        "mla_w_dkv": nrm(ks[11], (N_MLA_LAYERS, d, KV_LORA + QK_ROPE), d ** -0.5),
        "mla_kv_norm": gain(ks[12], (N_MLA_LAYERS, KV_LORA)),
        "mla_w_ukv": nrm(ks[13], (N_MLA_LAYERS, KV_LORA, N_HEADS * (QK_NOPE + V_HEAD)), KV_LORA ** -0.5),
        "mla_w_o": nrm(ks[14], (N_MLA_LAYERS, N_HEADS * V_HEAD, d), (N_HEADS * V_HEAD) ** -0.5),
        "conv_w_in": nrm(ks[15], (N_CONV_LAYERS, d, 3 * d), d ** -0.5),
        "conv_w": nrm(ks[16], (N_CONV_LAYERS, CONV_W, d), CONV_W ** -0.5),
        "conv_w_out": nrm(ks[17], (N_CONV_LAYERS, d, d), d ** -0.5),
        "ffn_w_gate": nrm(ks[18], (DEPTH, d, D_FF), d ** -0.5),
        "ffn_w_up": nrm(ks[19], (DEPTH, d, D_FF), d ** -0.5),
        "ffn_w_down": nrm(ks[20], (DEPTH, D_FF, d), D_FF ** -0.5),
        "final_norm": gain(ks[21], (d,)),
    }


def reference(x, c, ctx, c_ctx, ada_w, ada_b, norm_mix, norm_ffn,
              mla_w_dq, mla_q_norm, mla_w_uq, mla_w_dkv, mla_kv_norm, mla_w_ukv, mla_w_o,
              conv_w_in, conv_w, conv_w_out, ffn_w_gate, ffn_w_up, ffn_w_down, final_norm):
    d = D_MODEL
    ang_row, ang_col = axial_angles(x.shape[1])
    silu_c = jax.nn.silu(c)
    silu_cc = jax.nn.silu(c_ctx)
    for i in range(DEPTH):
        mixer = i % N_MIXERS
        j = i // N_MIXERS
        ctx_live = any(k % N_MIXERS == MIXER_MLA for k in range(i + 1, DEPTH))
        sh1, sc1, g1, sh2, sc2, g2 = jnp.split((silu_c @ ada_w[i] + ada_b[i])[:, None, :], 6, axis=-1)
        n_ctx_mod = 6 if ctx_live else (2 if mixer == MIXER_MLA else 0)
        mc = None
        if n_ctx_mod:
            mc = jnp.split(silu_cc @ ada_w[i][:, :n_ctx_mod * d] + ada_b[i][:n_ctx_mod * d], n_ctx_mod)
        h = modulate(rmsnorm(x, norm_mix[i]), sh1, sc1)
        if mixer == MIXER_MLA:
            h_c = modulate(rmsnorm(ctx, norm_mix[i]), mc[0], mc[1])
            y, y_c = mla_mixer(h, h_c, mla_w_dq[j], mla_q_norm[j], mla_w_uq[j], mla_w_dkv[j],
                               mla_kv_norm[j], mla_w_ukv[j], mla_w_o[j], ang_row, ang_col, ctx_live)
        else:
            y = short_conv(h, conv_w_in[j], conv_w[j], conv_w_out[j])
            y_c = None
            if ctx_live:
                h_c = modulate(rmsnorm(ctx, norm_mix[i]), mc[0], mc[1])
                y_c = short_conv(h_c, conv_w_in[j], conv_w[j], conv_w_out[j])
        x = x + g1 * y
        x = x + g2 * swiglu(modulate(rmsnorm(x, norm_ffn[i]), sh2, sc2),
                            ffn_w_gate[i], ffn_w_up[i], ffn_w_down[i])
        if ctx_live:
            ctx = ctx + mc[2] * y_c
            ctx = ctx + mc[5] * swiglu(modulate(rmsnorm(ctx, norm_ffn[i]), mc[3], mc[4]),
                                       ffn_w_gate[i], ffn_w_up[i], ffn_w_down[i])
    return rmsnorm(x, final_norm)
```

```cpp
#include <hip/hip_runtime.h>
#include <hip/hip_cooperative_groups.h>
#include <cstdio>
#include <cstdint>
namespace cg = cooperative_groups;

typedef unsigned short bf16_t;
typedef short bf16x8 __attribute__((ext_vector_type(8)));
typedef short s16x4 __attribute__((ext_vector_type(4)));
typedef float f32x4 __attribute__((ext_vector_type(4)));
typedef float f32x16 __attribute__((ext_vector_type(16)));
typedef unsigned u32x4 __attribute__((ext_vector_type(4)));
typedef unsigned u32x2 __attribute__((ext_vector_type(2)));
#define LAS __attribute__((address_space(3)))

constexpr int DM = 1024, NB = 4, SEQ = 8192, CTX = 256, NH = 8, DFF = 2816;
constexpr int MLAT = NB * SEQ;
constexpr int MCTX = NB * CTX;
constexpr int MALL = MLAT + MCTX;
constexpr int SKV = CTX + SEQ;
constexpr int DQK = 192;
constexpr float NORM_EPS = 1e-6f;

constexpr size_t MiB = 1u << 20;
constexpr size_t WS_MOD = 1 * MiB;
constexpr size_t WS_WQKVA = 2 * MiB;
constexpr size_t WS_WUQ = 3 * MiB;
constexpr size_t WS_WO = 4 * MiB;
constexpr size_t WS_WGU0 = 6 * MiB;
constexpr size_t WS_WD0 = 17 * MiB;
constexpr size_t WS_WIN = 23 * MiB;
constexpr size_t WS_WOUT = 29 * MiB;
constexpr size_t WS_WGU1 = 31 * MiB;
constexpr size_t WS_WD1 = 42 * MiB;
constexpr size_t WS_H = 48 * MiB;
constexpr size_t WS_BIG = 116 * MiB;
constexpr size_t WS_QKVA = WS_BIG;
constexpr size_t WS_QAN = WS_BIG + 33 * MiB;
constexpr size_t WS_KV = WS_BIG + 49 * MiB;
constexpr size_t WS_Q = WS_BIG + 64 * MiB;
constexpr size_t WS_O = WS_BIG + 160 * MiB;
constexpr size_t WS_G = WS_BIG;
constexpr size_t WS_CV = WS_BIG;
constexpr size_t WS_BG = WS_BIG + 64 * MiB;
constexpr size_t WS_Z = WS_BIG + 128 * MiB;
constexpr size_t WS_X16 = WS_BIG + 224 * MiB;
constexpr size_t WS_END = WS_BIG + 288 * MiB;
static_assert(WS_KV + (size_t)NB * SKV * DQK * 2 <= WS_Q && WS_QAN + (size_t)MLAT * 256 * 2 <= WS_KV && WS_QKVA + (size_t)MALL * 512 * 2 <= WS_QAN && WS_Q + (size_t)MLAT * 1536 * 2 <= WS_O && WS_O + (size_t)MLAT * DM * 2 <= WS_END && WS_G + (size_t)MLAT * DFF * 2 <= WS_END && WS_H + (size_t)MALL * DM * 2 <= WS_BIG, "ws map");

constexpr int LDS_BYTES = 163840;

typedef float f32x2_t __attribute__((ext_vector_type(2)));
typedef __bf16 bf16x2_t __attribute__((ext_vector_type(2)));
__device__ __forceinline__ unsigned pk_bf16(float lo, float hi) { const f32x2_t v = {lo, hi}; const bf16x2_t b = __builtin_convertvector(v, bf16x2_t); return __builtin_bit_cast(unsigned, b); }
__device__ __forceinline__ float bf_lo(unsigned u) { return __uint_as_float(u << 16); }
__device__ __forceinline__ float bf_hi(unsigned u) { return __uint_as_float(u & 0xffff0000u); }
__device__ __forceinline__ float wave_sum(float v) {
#pragma unroll
  for (int o = 32; o >= 1; o >>= 1) v += __shfl_xor(v, o);
  return v;
}
__device__ __forceinline__ int opaque_tid(int wsg) { int t; asm volatile("v_mbcnt_lo_u32_b32 %0, -1, 0\n\tv_mbcnt_hi_u32_b32 %0, -1, %0\n\tv_lshl_or_b32 %0, %1, 6, %0" : "=&v"(t) : "s"(wsg)); return t; }
__device__ __forceinline__ float silu_f(float x) { return x / (1.0f + __expf(-x)); }
__device__ __forceinline__ float rope_freq_rev(int i) { return __builtin_amdgcn_exp2f(-(float)i * (13.287712379549449f / 16.0f)) * 0.15915494309189535f; }
__device__ __forceinline__ void sincos_rev(float rev, float& s, float& c) { float f = rev - floorf(rev); s = __builtin_amdgcn_sinf(f); c = __builtin_amdgcn_cosf(f); }

namespace pg8 {
constexpr int BM = 256, BK = 64, HALF = 128, HTB = HALF * BK * 2, STAGE_BYTES = 8 * HTB, NXCD = 8, WGM = 8;
__device__ __forceinline__ int lds_byte(int r, int c) { const int st = (r >> 4) * 2 + (c >> 5), rr = r & 15, cc = c & 31, ob = rr * 64 + cc * 2; return st * 1024 + (ob ^ (((ob >> 9) & 1) << 5)); }
__device__ __forceinline__ void stage_rc(int b, int& R, int& C) { const int st = b / 1024, sb = b % 1024, swz = sb ^ (((sb >> 9) & 1) << 5); R = (st >> 1) * 16 + swz / 64; C = (st & 1) * 32 + (swz % 64) / 2; }
__device__ __forceinline__ int perm32(int rho) { const int n = rho >> 4, i = rho & 15; return 8 * (i >> 2) + 4 * n + (i & 3); }
struct Unit { int pm, pn; };
struct Gemm { const bf16_t* A; const bf16_t* Bt; int M, N, K; };
struct StaticOrder {
  int nM, nN, nwg, G, c;
  __device__ void init(int M, int N, int G_, int c_) { nM = M / BM; nN = N / BM; nwg = nM * nN; G = G_; c = c_; }
  __device__ bool next(int i, Unit& u) const {
    const long L = (long)i * G + c; if (L >= nwg) return false;
    int wgid = (int)L; { const int q = nwg / NXCD, r = nwg % NXCD, xcd = wgid % NXCD, off = wgid / NXCD; wgid = (xcd < r ? xcd * (q + 1) : r * (q + 1) + (xcd - r) * q) + off; }
    const int nig = WGM * nN, gid = wgid / nig, fm = gid * WGM, gsz = (nM - fm) < WGM ? (nM - fm) : WGM;
    u.pm = fm + ((wgid % nig) % gsz); u.pn = (wgid % nig) / gsz; return true;
  }
};

template <class Epi>
__device__ __forceinline__ void gemm_phase(int wsg, LAS unsigned char* lds, const Gemm g, const StaticOrder& S, const Epi& E) {
  const int tid = opaque_tid(wsg), wid = __builtin_amdgcn_readfirstlane(tid >> 6), lane = tid & 63, wr = wid >> 2, wc = wid & 3, fr = lane & 15, fq = lane >> 4;
  const int K = g.K, nt = K / BK;
  unsigned voffA[2], voffB[2];
#pragma unroll
  for (int i = 0; i < 2; ++i) { int R, C; stage_rc(tid * 16 + i * 8192, R, C); const int Rb = Epi::PERM ? ((R & ~31) + perm32(R & 31)) : R;
    voffA[i] = (unsigned)(R * K + C) * 2u; voffB[i] = (unsigned)(Rb * K + C) * 2u; }
  const size_t kstep = (size_t)(BK * 2);
  const size_t hstep = (size_t)HALF * K * 2;
  const size_t tstep = 2 * hstep;
  const unsigned ldsw = (unsigned)wid * 1024u;
  const int aoff = lds_byte(wr * 64 + fr, fq * 8), boff = lds_byte(wc * 32 + fr, fq * 8);
#define PG8_SA(b, h) (((b) * 2 + (h)) * HTB)
#define PG8_SB(b, h) ((4 + (b) * 2 + (h)) * HTB)
#define PG8_STAGE(bufoff, gbase, voff) do { _Pragma("unroll") for (int _i = 0; _i < 2; ++_i) \
    __builtin_amdgcn_global_load_lds((const unsigned*)((const char*)(gbase) + (voff)[_i]), (LAS unsigned*)(lds + (bufoff) + ldsw + _i * 8192), 16, 0, 0); } while (0)
#define PG8_LDA(dst, b, h) do { _Pragma("unroll") for (int m = 0; m < 4; ++m) _Pragma("unroll") for (int k = 0; k < 2; ++k) dst[m][k] = *(const LAS bf16x8*)(lds + PG8_SA(b, h) + aoff + m * 2048 + k * 1024); } while (0)
#define PG8_LDB(dst, b, h) do { _Pragma("unroll") for (int n = 0; n < 2; ++n) _Pragma("unroll") for (int k = 0; k < 2; ++k) dst[n][k] = *(const LAS bf16x8*)(lds + PG8_SB(b, h) + boff + n * 2048 + k * 1024); } while (0)
#define PG8_MMA(ai, bj, At, Bt) do { __builtin_amdgcn_s_setprio(1); _Pragma("unroll") for (int m = 0; m < 4; ++m) _Pragma("unroll") for (int n = 0; n < 2; ++n) _Pragma("unroll") for (int k = 0; k < 2; ++k) \
    acc[ai][bj][m][n] = __builtin_amdgcn_mfma_f32_16x16x32_bf16(Bt[n][k], At[m][k], acc[ai][bj][m][n], 0, 0, 0); __builtin_amdgcn_s_setprio(0); } while (0)
#define PG8_WAIT_V(n) asm volatile("s_waitcnt vmcnt(" #n ")" ::: "memory")
#define PG8_WAIT_L(n) asm volatile("s_waitcnt lgkmcnt(" #n ")" ::: "memory")
#define PG8_BAR __builtin_amdgcn_s_barrier()
#define PG8_SCHED __builtin_amdgcn_sched_barrier(0)
  Unit cur, nxt; int ui = 0;
  if (!S.next(0, cur)) return;
  f32x4 acc[2][2][4][2];
#pragma unroll
  for (int a = 0; a < 2; ++a)
#pragma unroll
    for (int b = 0; b < 2; ++b)
#pragma unroll
      for (int m = 0; m < 4; ++m)
#pragma unroll
        for (int n = 0; n < 2; ++n) acc[a][b][m][n] = (f32x4){0.f, 0.f, 0.f, 0.f};
  bf16x8 At[4][2], B0[2][2], B1[2][2];
  const char* cA = (const char*)g.A + (size_t)cur.pm * tstep; const char* cB = (const char*)g.Bt + (size_t)cur.pn * tstep;
  PG8_STAGE(PG8_SB(0, 0), cB, voffB); PG8_STAGE(PG8_SA(0, 0), cA, voffA); PG8_STAGE(PG8_SB(0, 1), cB + hstep, voffB); PG8_STAGE(PG8_SA(0, 1), cA + hstep, voffA);
  if (wr == 1) PG8_BAR;
  PG8_WAIT_V(4); PG8_BAR;
  PG8_STAGE(PG8_SB(1, 0), cB + kstep, voffB); PG8_STAGE(PG8_SA(1, 0), cA + kstep, voffA); PG8_STAGE(PG8_SB(1, 1), cB + hstep + kstep, voffB);
  PG8_WAIT_V(6); PG8_BAR;
  for (;;) {
    const bool has_next = S.next(ui + 1, nxt);
    const char* nA = has_next ? (const char*)g.A + (size_t)nxt.pm * tstep : cA; const char* nB = has_next ? (const char*)g.Bt + (size_t)nxt.pn * tstep : cB;
    for (int t = 0; t < nt; t += 2) {
      const bool last = (t == nt - 2);
      const char* a1 = cA + (size_t)(t + 1) * kstep;
      const char* a2 = last ? nA : cA + (size_t)(t + 2) * kstep; const char* b2 = last ? nB : cB + (size_t)(t + 2) * kstep;
      const char* a3 = a2 + kstep; const char* b3 = b2 + kstep;
      PG8_LDB(B0, 0, 0); PG8_SCHED; PG8_LDA(At, 0, 0); PG8_STAGE(PG8_SA(1, 1), a1 + hstep, voffA);
      PG8_WAIT_L(8); PG8_BAR; PG8_WAIT_L(0); PG8_MMA(0, 0, At, B0); PG8_BAR; PG8_SCHED;
      PG8_LDB(B1, 0, 1); PG8_STAGE(PG8_SB(0, 0), b2, voffB);
      PG8_BAR; PG8_WAIT_L(0); PG8_MMA(0, 1, At, B1); PG8_BAR;
      PG8_LDA(At, 0, 1); PG8_STAGE(PG8_SA(0, 0), a2, voffA);
      PG8_BAR; PG8_WAIT_L(0); PG8_MMA(1, 0, At, B0); PG8_BAR; PG8_SCHED;
      PG8_STAGE(PG8_SB(0, 1), b2 + hstep, voffB);
      PG8_WAIT_V(6); PG8_BAR; PG8_MMA(1, 1, At, B1); PG8_BAR;
      PG8_LDB(B0, 1, 0); PG8_SCHED; PG8_LDA(At, 1, 0); PG8_STAGE(PG8_SA(0, 1), a2 + hstep, voffA);
      PG8_WAIT_L(8); PG8_BAR; PG8_WAIT_L(0); PG8_MMA(0, 0, At, B0); PG8_BAR; PG8_SCHED;
      PG8_LDB(B1, 1, 1); PG8_STAGE(PG8_SB(1, 0), b3, voffB);
      PG8_BAR; PG8_WAIT_L(0); PG8_MMA(0, 1, At, B1); PG8_BAR;
      PG8_LDA(At, 1, 1); PG8_STAGE(PG8_SA(1, 0), a3, voffA);
      PG8_BAR; PG8_WAIT_L(0); PG8_MMA(1, 0, At, B0); PG8_BAR; PG8_SCHED;
      PG8_STAGE(PG8_SB(1, 1), b3 + hstep, voffB);
      PG8_WAIT_V(6); PG8_BAR; PG8_MMA(1, 1, At, B1); PG8_BAR;
    }
    E(acc, cur, wr, wc, fr, fq);
    if (!has_next) break;
#pragma unroll
    for (int a = 0; a < 2; ++a)
#pragma unroll
      for (int b = 0; b < 2; ++b)
#pragma unroll
        for (int m = 0; m < 4; ++m)
#pragma unroll
          for (int n = 0; n < 2; ++n) acc[a][b][m][n] = (f32x4){0.f, 0.f, 0.f, 0.f};
    cur = nxt; cA = nA; cB = nB; ++ui;
  }
  PG8_WAIT_V(0);
  if (wr == 0) PG8_BAR;
  PG8_BAR;
#undef PG8_SA
#undef PG8_SB
#undef PG8_STAGE
#undef PG8_LDA
#undef PG8_LDB
#undef PG8_MMA
#undef PG8_WAIT_V
#undef PG8_WAIT_L
#undef PG8_BAR
#undef PG8_SCHED
}

struct EpiBf16 {
  static constexpr bool PERM = true;
  bf16_t* O; int ldc;
  __device__ __forceinline__ void operator()(const f32x4 (&acc)[2][2][4][2], const Unit& u, int wr, int wc, int fr, int fq) const {
    const int row0 = u.pm * BM + wr * 64 + fr, col0 = u.pn * BM + wc * 32 + 8 * fq;
#pragma unroll
    for (int ai = 0; ai < 2; ++ai)
#pragma unroll
      for (int m = 0; m < 4; ++m) { bf16_t* rowp = O + (size_t)(row0 + ai * HALF + m * 16) * ldc + col0;
#pragma unroll
        for (int bj = 0; bj < 2; ++bj) { const f32x4 v0 = acc[ai][bj][m][0], v1 = acc[ai][bj][m][1];
          u32x4 w; w.x = pk_bf16(v0[0], v0[1]); w.y = pk_bf16(v0[2], v0[3]); w.z = pk_bf16(v1[0], v1[1]); w.w = pk_bf16(v1[2], v1[3]);
          *(u32x4*)(rowp + bj * HALF) = w; } }
  }
};
struct EpiQRope {
  static constexpr bool PERM = false;
  bf16_t* O;
  __device__ __forceinline__ void operator()(const f32x4 (&acc)[2][2][4][2], const Unit& u, int wr, int wc, int fr, int fq) const {
    const int row0 = u.pm * BM + wr * 64 + fr;
    float fr_rev[4];
#pragma unroll
    for (int j = 0; j < 4; ++j) fr_rev[j] = rope_freq_rev(4 * fq + j);
#pragma unroll
    for (int bj = 0; bj < 2; ++bj) {
      const int gq = u.pn * 8 + bj * 4 + wc;
      const int within = gq % 6;
      const int col0 = gq * 32 + 4 * fq;
#pragma unroll
      for (int ai = 0; ai < 2; ++ai)
#pragma unroll
        for (int m = 0; m < 4; ++m) {
          const int row = row0 + ai * HALF + m * 16;
          f32x4 v0 = acc[ai][bj][m][0], v1 = acc[ai][bj][m][1];
          if (within >= 4) {
            const int t = row & (SEQ - 1);
            const float pos = (float)(within == 4 ? (t >> 6) : (t & 63));
#pragma unroll
            for (int j = 0; j < 4; ++j) { float s, c; sincos_rev(pos * fr_rev[j], s, c);
              const float x1 = v0[j], x2 = v1[j]; v0[j] = x1 * c - x2 * s; v1[j] = x2 * c + x1 * s; }
          }
          bf16_t* rowp = O + (size_t)row * 1536 + col0;
          u32x2 w0, w1; w0.x = pk_bf16(v0[0], v0[1]); w0.y = pk_bf16(v0[2], v0[3]); w1.x = pk_bf16(v1[0], v1[1]); w1.y = pk_bf16(v1[2], v1[3]);
          *(u32x2*)(rowp) = w0; *(u32x2*)(rowp + 16) = w1;
        }
    }
  }
};
template <bool XIN_F32>
struct EpiResid {
  static constexpr bool PERM = true;
  const void* xin; bf16_t* xout; const float* gate;
  __device__ __forceinline__ void operator()(const f32x4 (&acc)[2][2][4][2], const Unit& u, int wr, int wc, int fr, int fq) const {
    const int row0 = u.pm * BM + wr * 64 + fr, col0 = u.pn * BM + wc * 32 + 8 * fq;
    const float* gp = gate + (size_t)((u.pm * BM) / SEQ) * 6144 + col0;
    f32x4 gv[2][2];
#pragma unroll
    for (int bj = 0; bj < 2; ++bj)
#pragma unroll
      for (int n = 0; n < 2; ++n) gv[bj][n] = *(const f32x4*)(gp + bj * HALF + n * 4);
    f32x4 xa[2][2], xb[2][2];
#define EPR_LOAD(X, g) do { const size_t off_ = (size_t)(row0 + ((g) >> 2) * HALF + ((g) & 3) * 16) * DM + col0; \
      _Pragma("unroll") for (int bj = 0; bj < 2; ++bj) { \
        if (XIN_F32) { X[bj][0] = *(const f32x4*)((const float*)xin + off_ + bj * HALF); X[bj][1] = *(const f32x4*)((const float*)xin + off_ + bj * HALF + 4); } \
        else { const u32x4 t_ = *(const u32x4*)((const bf16_t*)xin + off_ + bj * HALF); X[bj][0] = (f32x4){bf_lo(t_.x), bf_hi(t_.x), bf_lo(t_.y), bf_hi(t_.y)}; X[bj][1] = (f32x4){bf_lo(t_.z), bf_hi(t_.z), bf_lo(t_.w), bf_hi(t_.w)}; } } } while (0)
#define EPR_STORE(X, g) do { const size_t off_ = (size_t)(row0 + ((g) >> 2) * HALF + ((g) & 3) * 16) * DM + col0; \
      _Pragma("unroll") for (int bj = 0; bj < 2; ++bj) { const f32x4 v0_ = X[bj][0] + gv[bj][0] * acc[(g) >> 2][bj][(g) & 3][0], v1_ = X[bj][1] + gv[bj][1] * acc[(g) >> 2][bj][(g) & 3][1]; \
        u32x4 w_; w_.x = pk_bf16(v0_[0], v0_[1]); w_.y = pk_bf16(v0_[2], v0_[3]); w_.z = pk_bf16(v1_[0], v1_[1]); w_.w = pk_bf16(v1_[2], v1_[3]); *(u32x4*)(xout + off_ + bj * HALF) = w_; } } while (0)
    EPR_LOAD(xa, 0); EPR_LOAD(xb, 1);
    EPR_STORE(xa, 0); EPR_LOAD(xa, 2); EPR_STORE(xb, 1); EPR_LOAD(xb, 3);
    EPR_STORE(xa, 2); EPR_LOAD(xa, 4); EPR_STORE(xb, 3); EPR_LOAD(xb, 5);
    EPR_STORE(xa, 4); EPR_LOAD(xa, 6); EPR_STORE(xb, 5); EPR_LOAD(xb, 7);
    EPR_STORE(xa, 6); EPR_STORE(xb, 7);
#undef EPR_LOAD
#undef EPR_STORE
  }
};
struct EpiSwiglu {
  static constexpr bool PERM = true;
  bf16_t* O; int ldc;
  __device__ __forceinline__ void operator()(const f32x4 (&acc)[2][2][4][2], const Unit& u, int wr, int wc, int fr, int fq) const {
    const int row0 = u.pm * BM + wr * 64 + fr, col0 = u.pn * HALF + wc * 32 + 8 * fq;
#pragma unroll
    for (int ai = 0; ai < 2; ++ai)
#pragma unroll
      for (int m = 0; m < 4; ++m) { float r[8];
#pragma unroll
        for (int n = 0; n < 2; ++n) { const f32x4 g = acc[ai][0][m][n], up = acc[ai][1][m][n];
#pragma unroll
          for (int j = 0; j < 4; ++j) r[4 * n + j] = g[j] * __builtin_amdgcn_rcpf(1.0f + __builtin_amdgcn_exp2f(-g[j] * 1.4426950408889634f)) * up[j]; }
        u32x4 w; w.x = pk_bf16(r[0], r[1]); w.y = pk_bf16(r[2], r[3]); w.z = pk_bf16(r[4], r[5]); w.w = pk_bf16(r[6], r[7]);
        *(u32x4*)(O + (size_t)(row0 + ai * HALF + m * 16) * ldc + col0) = w; }
  }
};
struct EpiConvIn {
  static constexpr bool PERM = true;
  bf16_t* CV; bf16_t* BG;
  __device__ __forceinline__ void operator()(const f32x4 (&acc)[2][2][4][2], const Unit& u, int wr, int wc, int fr, int fq) const {
    const int row0 = u.pm * BM + wr * 64 + fr;
#pragma unroll
    for (int ai = 0; ai < 2; ++ai)
#pragma unroll
      for (int m = 0; m < 4; ++m) { const size_t row = (size_t)(row0 + ai * HALF + m * 16);
        if (u.pn < 8) { const f32x4 r0 = acc[ai][0][m][0] * acc[ai][1][m][0], r1 = acc[ai][0][m][1] * acc[ai][1][m][1];
          u32x4 w; w.x = pk_bf16(r0[0], r0[1]); w.y = pk_bf16(r0[2], r0[3]); w.z = pk_bf16(r1[0], r1[1]); w.w = pk_bf16(r1[2], r1[3]);
          *(u32x4*)(CV + row * DM + u.pn * HALF + wc * 32 + 8 * fq) = w;
        } else {
#pragma unroll
          for (int bj = 0; bj < 2; ++bj) { const f32x4 a = acc[ai][bj][m][0], b = acc[ai][bj][m][1];
            u32x4 w; w.x = pk_bf16(a[0], a[1]); w.y = pk_bf16(a[2], a[3]); w.z = pk_bf16(b[0], b[1]); w.w = pk_bf16(b[2], b[3]);
            *(u32x4*)(BG + row * DM + (u.pn - 8) * BM + bj * HALF + wc * 32 + 8 * fq) = w; } } }
  }
};
}

namespace att {
constexpr int NW = 8, QBLK = 32, KVBLK = 64;
constexpr int LDQ = 1536, LDK = DQK, LDO = 1024;
constexpr float SCALE = 0.07216878364870322f;
constexpr float THR = 8.f;
constexpr int SHM_V = KVBLK * 128 * 2, SHM_K = KVBLK * DQK * 2;
constexpr int SHM_ATTN = 2 * SHM_V + 2 * SHM_K + NW * 64 * 4;
#define KSWZ(row, colB) ((row) * 384 + ((colB) ^ ((((row) >> 1) & 7) << 4)))
#define SBAR() __builtin_amdgcn_sched_barrier(0)
__device__ __forceinline__ int crow(int r, int hi) { return (r & 3) + 8 * (r >> 2) + 4 * hi; }
__device__ __forceinline__ unsigned cvtpk(float lo, float hi) { return pk_bf16(lo, hi); }

__device__ __forceinline__ void partialSM(f32x16& p0, f32x16& p1, float& m_reg, float& mn, float& alpha) {
  constexpr float C = SCALE * 1.4426950408889634f;
  float pmax = p0[0];
#pragma unroll
  for (int r = 1; r < 16; ++r) pmax = fmaxf(pmax, p0[r]);
#pragma unroll
  for (int r = 0; r < 16; ++r) pmax = fmaxf(pmax, p1[r]);
  { auto rr = __builtin_amdgcn_permlane32_swap(__float_as_uint(pmax), __float_as_uint(pmax), false, false);
    pmax = fmaxf(__uint_as_float(rr[0]), __uint_as_float(rr[1])); }
  if (__builtin_expect(__all(pmax - m_reg <= THR / SCALE), 1)) { mn = m_reg; alpha = 1.f; }
  else { mn = fmaxf(m_reg, pmax); alpha = __builtin_amdgcn_exp2f((m_reg - mn) * C); m_reg = mn; }
  float mnC = -mn * C;
#pragma unroll
  for (int r = 0; r < 16; ++r) p0[r] = fmaf(p0[r], C, mnC);
#pragma unroll
  for (int r = 0; r < 16; ++r) p1[r] = fmaf(p1[r], C, mnC);
#pragma unroll
  for (int r = 0; r < 16; ++r) p0[r] = __builtin_amdgcn_exp2f(p0[r]);
}
__device__ __forceinline__ void finishSM(f32x16& p0, f32x16& p1, float alpha, float& l_reg, bf16x8& pa0, bf16x8& pa1, bf16x8& pa2, bf16x8& pa3) {
#pragma unroll
  for (int r = 0; r < 16; ++r) p1[r] = __builtin_amdgcn_exp2f(p1[r]);
  float ps = 0;
#pragma unroll
  for (int r = 0; r < 16; ++r) ps += p0[r];
#pragma unroll
  for (int r = 0; r < 16; ++r) ps += p1[r];
  { auto rr = __builtin_amdgcn_permlane32_swap(__float_as_uint(ps), __float_as_uint(ps), false, false);
    ps = __uint_as_float(rr[0]) + __uint_as_float(rr[1]); }
  l_reg = l_reg * alpha + ps;
#define PK4(P, BASE, OUT) do { unsigned a0 = cvtpk(P[BASE + 0], P[BASE + 1]), a1 = cvtpk(P[BASE + 2], P[BASE + 3]);   \
    unsigned b0 = cvtpk(P[BASE + 4], P[BASE + 5]), b1 = cvtpk(P[BASE + 6], P[BASE + 7]);                              \
    auto r0 = __builtin_amdgcn_permlane32_swap(a0, b0, false, false); auto r1 = __builtin_amdgcn_permlane32_swap(a1, b1, false, false); \
    u32x4 w = {r0[0], r1[0], r0[1], r1[1]}; OUT = *reinterpret_cast<bf16x8*>(&w); } while (0)
  PK4(p0, 0, pa0); PK4(p0, 8, pa1); PK4(p1, 0, pa2); PK4(p1, 8, pa3);
#undef PK4
}
__device__ __forceinline__ void qkt(f32x16& p0, f32x16& p1, const char* Ks, const bf16x8* qr, int r32, int hi) {
  p0 = f32x16{}; p1 = f32x16{};
#pragma unroll
  for (int d0 = 0; d0 < 12; ++d0) { int cb = (d0 * 16 + hi * 8) * 2;
    bf16x8 b0 = *reinterpret_cast<const bf16x8*>(Ks + KSWZ(r32, cb));
    bf16x8 b1 = *reinterpret_cast<const bf16x8*>(Ks + KSWZ(32 + r32, cb));
    p0 = __builtin_amdgcn_mfma_f32_32x32x16_bf16(b0, qr[d0], p0, 0, 0, 0);
    p1 = __builtin_amdgcn_mfma_f32_32x32x16_bf16(b1, qr[d0], p1, 0, 0, 0);
    if ((d0 & 3) == 3 && d0 != 11) SBAR(); }
}
__device__ __forceinline__ int v_st(int k, int c) { const int kk = (k & ~0xC) | ((k & 4) << 1) | ((k & 8) >> 1); return ((kk >> 3) * 4 + (c >> 5)) * 512 + ((kk & 7) * 32 + (c & 31)) * 2; }
__device__ __forceinline__ int v_rd_base(int lane) { return ((lane & 3) << 3) | (((lane >> 2) & 3) << 6) | (((lane >> 4) & 1) << 5) | (((lane >> 5) & 1) << 8); }
constexpr int v_rd_off(int d0, int ks, int half) { return d0 * 512 + ks * 4096 + half * 2048; }
template <int OFF> __device__ __forceinline__ s16x4 tr_read(int vb) {
  s16x4 r; asm volatile("ds_read_b64_tr_b16 %0, %1 offset:%2" : "=&v"(r) : "v"(vb), "i"(OFF) : "memory"); return r;
}
template <int D0> __device__ __forceinline__ void pv_one(f32x16& od, int vb, bf16x8 pa0, bf16x8 pa1, bf16x8 pa2, bf16x8 pa3) {
  const s16x4 l0 = tr_read<v_rd_off(D0, 0, 0)>(vb), h0 = tr_read<v_rd_off(D0, 0, 1)>(vb), l1 = tr_read<v_rd_off(D0, 1, 0)>(vb), h1 = tr_read<v_rd_off(D0, 1, 1)>(vb);
  const s16x4 l2 = tr_read<v_rd_off(D0, 2, 0)>(vb), h2 = tr_read<v_rd_off(D0, 2, 1)>(vb), l3 = tr_read<v_rd_off(D0, 3, 0)>(vb), h3 = tr_read<v_rd_off(D0, 3, 1)>(vb);
  asm volatile("s_waitcnt lgkmcnt(0)" ::: "memory"); SBAR();
#define PK(L, H) (bf16x8){L[0], L[1], L[2], L[3], H[0], H[1], H[2], H[3]}
  od = __builtin_amdgcn_mfma_f32_32x32x16_bf16(pa0, PK(l0, h0), od, 0, 0, 0);
  od = __builtin_amdgcn_mfma_f32_32x32x16_bf16(pa1, PK(l1, h1), od, 0, 0, 0);
  od = __builtin_amdgcn_mfma_f32_32x32x16_bf16(pa2, PK(l2, h2), od, 0, 0, 0);
  od = __builtin_amdgcn_mfma_f32_32x32x16_bf16(pa3, PK(l3, h3), od, 0, 0, 0);
#undef PK
}
__device__ __forceinline__ void pv_d0(f32x16* o, int vb, bf16x8 pa0, bf16x8 pa1, bf16x8 pa2, bf16x8 pa3) {
  pv_one<0>(o[0], vb, pa0, pa1, pa2, pa3); pv_one<1>(o[1], vb, pa0, pa1, pa2, pa3); pv_one<2>(o[2], vb, pa0, pa1, pa2, pa3); pv_one<3>(o[3], vb, pa0, pa1, pa2, pa3);
}

constexpr int SLOT = SHM_K + SHM_V;
constexpr int NTILE = SKV / KVBLK;
static_assert(NTILE % 6 == 0, "tile loop is unrolled by 6");
constexpr int ATT_WS = 3 * SLOT;
__device__ __forceinline__ void attn_unit(int wsg, const bf16_t* __restrict__ Qb, const bf16_t* __restrict__ Kh, bf16_t* __restrict__ Ob, LAS unsigned char* ldsl) {
  const int tid = opaque_tid(wsg), wid = __builtin_amdgcn_readfirstlane(tid >> 6), lane = tid & 63, r32 = lane & 31, hi = lane >> 5;
  LAS float* ws = (LAS float*)(ldsl + ATT_WS) + wid * 64; LAS float* li_l = ws; LAS float* al_l = ws + 32;
  float m_reg = -1e30f, l_reg = 0; f32x16 o[4] = {}; bf16x8 qr[8];
  const bf16_t* Qw = Qb + (long)(wid * QBLK + r32) * LDQ + hi * 8;
#pragma unroll
  for (int d0 = 0; d0 < 8; ++d0) qr[d0] = *reinterpret_cast<const bf16x8*>(Qw + d0 * 16);
  LAS bf16x8* qlds = (LAS bf16x8*)(ldsl + ATT_WS + 2048 + wid * 4096) + lane;
#pragma unroll
  for (int i = 0; i < 4; ++i) qlds[i * 64] = *reinterpret_cast<const bf16x8*>(Qw + (8 + i) * 16);
  unsigned soff[5];
#pragma unroll
  for (int i = 0; i < 5; ++i) { const int ob = (wid * 5 + i) * 1024 + lane * 16;
    if (ob < SHM_K) { const int row = ob / 384, cph = ob % 384; soff[i] = (unsigned)(row * 384 + (cph ^ (((row >> 1) & 7) << 4))); }
    else { const int o2 = ob - SHM_K, st = o2 >> 9, wi = o2 & 511, kk = (st >> 2) * 8 + (wi >> 6), cc = (wi & 63) >> 1, cg = st & 3;
      const int k = (kk & ~0xC) | ((kk & 4) << 1) | ((kk & 8) >> 1); soff[i] = (unsigned)(k * 384 + (cg * 32 + cc) * 2); } }
  const int tsw = (hi * 16) ^ (((r32 >> 1) & 7) << 4);
  int kbs[4];
#pragma unroll
  for (int m = 0; m < 4; ++m) kbs[m] = r32 * 384 + ((m * 32) ^ tsw);
  const int vb0 = (int)(uintptr_t)(ldsl + SHM_K) + v_rd_base(lane);
#define ISSUE(SI, TI) do { const char* gb_ = (const char*)Kh + (size_t)(TI) * (KVBLK * 384); asm volatile("" : "+s"(gb_)); \
    _Pragma("unroll") for (int i_ = 0; i_ < 5; ++i_) __builtin_amdgcn_global_load_lds((const unsigned*)(gb_ + soff[i_]), (LAS unsigned*)(ldsl + (SI) * SLOT + (wid * 5 + i_) * 1024), 16, 0, 0); } while (0)
#define WAITBAR() asm volatile("s_waitcnt vmcnt(0) lgkmcnt(0)\n\ts_barrier" ::: "memory")
#define RESC(a) do { if (__any((a) < 1.f)) { if (hi == 0) al_l[r32] = (a); asm volatile("s_waitcnt lgkmcnt(0)" ::: "memory"); \
    _Pragma("unroll") for (int d = 0; d < 4; ++d) _Pragma("unroll") for (int r = 0; r < 16; ++r) o[d][r] *= al_l[crow(r, hi)]; } } while (0)
#define KLD(d0, SK, H) (*(const LAS bf16x8*)(ldsl + kbs[(d0) & 3] + ((SK) * SLOT + ((d0) >> 2) * 128 + (H) * (32 * 384))))
#define QKT(P0, P1, SK) do { P0 = f32x16{}; P1 = f32x16{}; \
    _Pragma("unroll") for (int d0 = 0; d0 < 12; ++d0) { \
      const bf16x8 b0_ = KLD(d0, SK, 0); const bf16x8 b1_ = KLD(d0, SK, 1); \
      bf16x8 qf_; if (d0 < 8) qf_ = qr[d0 < 8 ? d0 : 0]; else qf_ = qlds[(d0 - 8) * 64]; \
      P0 = __builtin_amdgcn_mfma_f32_32x32x16_bf16(b0_, qf_, P0, 0, 0, 0); \
      P1 = __builtin_amdgcn_mfma_f32_32x32x16_bf16(b1_, qf_, P1, 0, 0, 0); } } while (0)
#define QKT_SCHED() do { __builtin_amdgcn_sched_group_barrier(0x100, 2, 0); \
    _Pragma("unroll") for (int d0 = 0; d0 < 12; ++d0) { \
      __builtin_amdgcn_sched_group_barrier(0x008, 1, 0); __builtin_amdgcn_sched_group_barrier(0x400, 1, 0); __builtin_amdgcn_sched_group_barrier(0x002, 3, 0); \
      if (d0 < 7) __builtin_amdgcn_sched_group_barrier(0x100, 2, 0); else if (d0 < 11) __builtin_amdgcn_sched_group_barrier(0x100, 3, 0); \
      __builtin_amdgcn_sched_group_barrier(0x008, 1, 0); __builtin_amdgcn_sched_group_barrier(0x400, 1, 0); __builtin_amdgcn_sched_group_barrier(0x002, 3, 0); } } while (0)
#define PSM_A(P0, P1) do { pmax_ = P0[0]; _Pragma("unroll") for (int r = 1; r < 16; ++r) pmax_ = fmaxf(pmax_, P0[r]); _Pragma("unroll") for (int r = 0; r < 16; ++r) pmax_ = fmaxf(pmax_, P1[r]); } while (0)
#define PSM_B(P0, P1, MN, AL) do { constexpr float C_ = SCALE * 1.4426950408889634f; \
    { auto rr_ = __builtin_amdgcn_permlane32_swap(__float_as_uint(pmax_), __float_as_uint(pmax_), false, false); pmax_ = fmaxf(__uint_as_float(rr_[0]), __uint_as_float(rr_[1])); } \
    const bool keep_ = __all(pmax_ - m_reg <= THR / SCALE); const float mc_ = fmaxf(m_reg, pmax_); const float a2_ = __builtin_amdgcn_exp2f((m_reg - mc_) * C_); \
    MN = keep_ ? m_reg : mc_; AL = keep_ ? 1.f : a2_; m_reg = MN; mnC_ = -MN * C_; \
    _Pragma("unroll") for (int r = 0; r < 16; ++r) P0[r] = fmaf(P0[r], C_, mnC_); } while (0)
#define PSM_C(P0, P1) do { constexpr float C_ = SCALE * 1.4426950408889634f; \
    _Pragma("unroll") for (int r = 0; r < 16; ++r) P1[r] = fmaf(P1[r], C_, mnC_); \
    _Pragma("unroll") for (int r = 0; r < 4; ++r) P0[r] = __builtin_amdgcn_exp2f(P0[r]); } while (0)
#define PSM_D(P0) do { _Pragma("unroll") for (int r = 4; r < 16; ++r) P0[r] = __builtin_amdgcn_exp2f(P0[r]); } while (0)
#define HALF(PX0, PX1, MNX, ALX, PY0, PY1, ALY, SK, SV, SI, TI) do { \
    WAITBAR(); \
    if ((TI) < NTILE) ISSUE(SI, TI); \
    SBAR(); QKT(PX0, PX1, SK); \
    finishSM(PY0, PY1, ALY, l_reg, pa0, pa1, pa2, pa3); QKT_SCHED(); SBAR(); \
    { float pmax_, mnC_; const int vb_ = vb0 + (SV) * SLOT; \
      pv_one<0>(o[0], vb_, pa0, pa1, pa2, pa3); PSM_A(PX0, PX1); \
      pv_one<1>(o[1], vb_, pa0, pa1, pa2, pa3); PSM_B(PX0, PX1, MNX, ALX); \
      pv_one<2>(o[2], vb_, pa0, pa1, pa2, pa3); PSM_C(PX0, PX1); \
      pv_one<3>(o[3], vb_, pa0, pa1, pa2, pa3); PSM_D(PX0); asm volatile("" : "+v"(PX0), "+v"(PX1)); } \
    RESC(ALX); } while (0)
  f32x16 pA0, pA1, pB0, pB1; float mnA, mnB, alA, alB; bf16x8 pa0, pa1, pa2, pa3;
  ISSUE(0, 0); WAITBAR(); ISSUE(1, 1);
  QKT(pA0, pA1, 0); partialSM(pA0, pA1, m_reg, mnA, alA);
  for (int j = 1; j + 5 < NTILE; j += 6) {
    HALF(pB0, pB1, mnB, alB, pA0, pA1, alA, 1, 0, 2, j + 1);
    HALF(pA0, pA1, mnA, alA, pB0, pB1, alB, 2, 1, 0, j + 2);
    HALF(pB0, pB1, mnB, alB, pA0, pA1, alA, 0, 2, 1, j + 3);
    HALF(pA0, pA1, mnA, alA, pB0, pB1, alB, 1, 0, 2, j + 4);
    HALF(pB0, pB1, mnB, alB, pA0, pA1, alA, 2, 1, 0, j + 5);
    HALF(pA0, pA1, mnA, alA, pB0, pB1, alB, 0, 2, 1, j + 6);
  }
  HALF(pB0, pB1, mnB, alB, pA0, pA1, alA, 1, 0, 2, NTILE - 4);
  HALF(pA0, pA1, mnA, alA, pB0, pB1, alB, 2, 1, 0, NTILE - 3);
  HALF(pB0, pB1, mnB, alB, pA0, pA1, alA, 0, 2, 1, NTILE - 2);
  HALF(pA0, pA1, mnA, alA, pB0, pB1, alB, 1, 0, 2, NTILE - 1);
  HALF(pB0, pB1, mnB, alB, pA0, pA1, alA, 2, 1, 0, NTILE);
  finishSM(pB0, pB1, alB, l_reg, pa0, pa1, pa2, pa3); SBAR();
  pv_d0(o, vb0 + 2 * SLOT, pa0, pa1, pa2, pa3);
  if (hi == 0) li_l[r32] = l_reg; asm volatile("s_waitcnt lgkmcnt(0)" ::: "memory");
  bf16_t* Ow = Ob + (long)(wid * QBLK) * LDO;
#pragma unroll
  for (int r = 0; r < 16; ++r) { const int orow = crow(r, hi); const float rli = __builtin_amdgcn_rcpf(li_l[orow]);
#pragma unroll
    for (int d0 = 0; d0 < 4; ++d0) Ow[(long)orow * LDO + d0 * 32 + r32] = (bf16_t)(pk_bf16(o[d0][r] * rli, 0.f) & 0xffffu); }
#undef ISSUE
#undef WAITBAR
#undef RESC
#undef QKT
#undef PSM_A
#undef PSM_B
#undef PSM_C
#undef PSM_D
#undef QKT_SCHED
#undef KLD
#undef HALF
}
}

struct Params {
  const float* x; const float* c; const float* ctx; const float* c_ctx; const float* ada_w; const float* ada_b; const float* norm_mix; const float* norm_ffn;
  const float* w_dq; const float* q_norm; const float* w_uq; const float* w_dkv; const float* kv_norm; const float* w_ukv; const float* w_o;
  const float* conv_w_in; const float* conv_w; const float* conv_w_out; const float* w_gate; const float* w_up; const float* w_down; const float* final_norm;
  float* out; unsigned char* ws;
};

template <bool FINAL, bool SRC16>
__device__ __forceinline__ void norm_rows(int wsg, const float* src_lat, const float* src_ctx, const bf16_t* src16, int nrows, const float* w, const float* mod, int sh_off, int sc_off, bf16_t* H, float* outf) {
  const int tid_ = opaque_tid(wsg); const int lane = tid_ & 63, wv = blockIdx.x * 8 + (tid_ >> 6), nw = gridDim.x * 8;
  f32x4 wv4[4];
#pragma unroll
  for (int i = 0; i < 2; ++i) { wv4[2 * i] = *(const f32x4*)(w + i * 512 + lane * 8); wv4[2 * i + 1] = *(const f32x4*)(w + i * 512 + lane * 8 + 4); }
  for (int row = wv; row < nrows; row += nw) {
    f32x4 v[4]; float ss = 0.f;
    if (SRC16) { const bf16_t* xp = src16 + (size_t)row * DM;
#pragma unroll
      for (int i = 0; i < 2; ++i) { const u32x4 t = *(const u32x4*)(xp + i * 512 + lane * 8); v[2 * i] = (f32x4){bf_lo(t.x), bf_hi(t.x), bf_lo(t.y), bf_hi(t.y)}; v[2 * i + 1] = (f32x4){bf_lo(t.z), bf_hi(t.z), bf_lo(t.w), bf_hi(t.w)}; }
    } else { const float* xp = row < MLAT ? src_lat + (size_t)row * DM : src_ctx + (size_t)(row - MLAT) * DM;
#pragma unroll
      for (int i = 0; i < 2; ++i) { v[2 * i] = *(const f32x4*)(xp + i * 512 + lane * 8); v[2 * i + 1] = *(const f32x4*)(xp + i * 512 + lane * 8 + 4); } }
#pragma unroll
    for (int i = 0; i < 4; ++i) ss += v[i][0] * v[i][0] + v[i][1] * v[i][1] + v[i][2] * v[i][2] + v[i][3] * v[i][3];
    ss = wave_sum(ss);
    const float rstd = rsqrtf(ss * (1.0f / DM) + NORM_EPS);
    if (FINAL) {
#pragma unroll
      for (int i = 0; i < 2; ++i) { *(f32x4*)(outf + (size_t)row * DM + i * 512 + lane * 8) = v[2 * i] * rstd * wv4[2 * i]; *(f32x4*)(outf + (size_t)row * DM + i * 512 + lane * 8 + 4) = v[2 * i + 1] * rstd * wv4[2 * i + 1]; }
    } else {
      const int mr = row < MLAT ? row / SEQ : 4;
      const float* mp = mod + (size_t)mr * 6144;
#pragma unroll
      for (int i = 0; i < 2; ++i) { const int c = i * 512 + lane * 8;
        const f32x4 sh0 = *(const f32x4*)(mp + sh_off + c), sh1 = *(const f32x4*)(mp + sh_off + c + 4), sc0 = *(const f32x4*)(mp + sc_off + c), sc1 = *(const f32x4*)(mp + sc_off + c + 4);
        const f32x4 h0 = v[2 * i] * rstd * wv4[2 * i] * (1.0f + sc0) + sh0, h1 = v[2 * i + 1] * rstd * wv4[2 * i + 1] * (1.0f + sc1) + sh1;
        u32x4 o; o.x = pk_bf16(h0[0], h0[1]); o.y = pk_bf16(h0[2], h0[3]); o.z = pk_bf16(h1[0], h1[1]); o.w = pk_bf16(h1[2], h1[3]);
        *(u32x4*)(H + (size_t)row * DM + c) = o; }
    }
  }
}

typedef const __attribute__((address_space(4))) Params* ParamsK;
__device__ __forceinline__ ParamsK kparams() { auto kp = __builtin_amdgcn_kernarg_segment_ptr(); asm volatile("" : "+s"(kp)); return (ParamsK)kp; }
#define WSP(T, OFF) ((T*)(q->ws + (OFF)))

__device__ __forceinline__ void phase_adaln(int wsg, unsigned char* shm) {
  ParamsK q = kparams();
  const int tid = opaque_tid(wsg), lane = tid & 63, wid = tid >> 6;
  const int G = gridDim.x, bid = blockIdx.x;
  float* lds_f = (float*)shm;
  float* mod = WSP(float, WS_MOD);
  for (int it = bid; it < 2 * 96; it += G) {
    const int layer = it / 96, n0 = (it % 96) * 64;
    float* sv = lds_f;
    float* part = lds_f + 5 * 1024;
    const float* cp = q->c; const float* ccp = q->c_ctx;
    for (int e = tid; e < 5 * 1024; e += 512) { const int r = e >> 10, k = e & 1023; const float cv = r < 4 ? cp[r * DM + k] : ccp[k]; sv[e] = silu_f(cv); }
    __syncthreads();
    float a0 = 0.f, a1 = 0.f, a2 = 0.f, a3 = 0.f, a4 = 0.f;
    const float* wp = q->ada_w + (size_t)layer * DM * 6144 + n0 + lane;
    for (int k = wid * 128; k < wid * 128 + 128; ++k) { const float wv = wp[(size_t)k * 6144];
      a0 += sv[k] * wv; a1 += sv[1024 + k] * wv; a2 += sv[2048 + k] * wv; a3 += sv[3072 + k] * wv; a4 += sv[4096 + k] * wv; }
    part[(wid * 5 + 0) * 64 + lane] = a0; part[(wid * 5 + 1) * 64 + lane] = a1; part[(wid * 5 + 2) * 64 + lane] = a2; part[(wid * 5 + 3) * 64 + lane] = a3; part[(wid * 5 + 4) * 64 + lane] = a4;
    __syncthreads();
    if (tid < 320) { const int r = tid >> 6, l = tid & 63; float s = 0.f;
#pragma unroll
      for (int w8 = 0; w8 < 8; ++w8) s += part[(w8 * 5 + r) * 64 + l];
      mod[((size_t)layer * 5 + r) * 6144 + n0 + l] = s + q->ada_b[layer * 6144 + n0 + l]; }
    __syncthreads();
  }
}
__device__ __forceinline__ void phase_prologue(int wsg, unsigned char* shm) {
  ParamsK q = kparams();
  const int tid = opaque_tid(wsg);
  const int G = gridDim.x, bid = blockIdx.x;
  float* lds_f = (float*)shm;
  {
    constexpr int T_QKVA = 8 * 16, T_GU = 88 * 16, T_D = 16 * 44, T_IN = 48 * 16, T_OUT = 16 * 16;
    constexpr int T_TOTAL = T_QKVA + 2 * T_GU + 2 * T_D + T_IN + T_OUT;
    const int t = tid, chunk = (t & 15) >> 2, cc = (t & 3) * 4;
    struct TItem { const float* sp; int ld; bf16_t* dst; int Kdst; int n0, k0; };
    auto decode = [&](int it) -> TItem { TItem r; int i = it;
      if (i < T_QKVA) { const int tn = i / 16, tk = i % 16, n16 = tn * 64 + 16 * chunk; r.n0 = tn * 64; r.k0 = tk * 64; r.dst = WSP(bf16_t, WS_WQKVA); r.Kdst = DM;
        if (tn < 4) { r.sp = q->w_dq + n16; r.ld = 256; } else { r.sp = n16 < 448 ? q->w_dkv + (n16 - 256) : (const float*)nullptr; r.ld = 192; } return r; }
      i -= T_QKVA;
      for (int layer = 0; layer < 2; ++layer) {
        if (i < T_GU) { const int tn = i / 16, tk = i % 16, n16 = tn * 64 + 16 * chunk; r.n0 = tn * 64; r.k0 = tk * 64; r.dst = WSP(bf16_t, layer ? WS_WGU1 : WS_WGU0); r.Kdst = DM; r.ld = DFF;
          r.sp = ((n16 & 128) ? q->w_up : q->w_gate) + (size_t)layer * DM * DFF + (n16 >> 8) * 128 + (n16 & 127); return r; }
        i -= T_GU;
        if (i < T_D) { const int tn = i / 44, tk = i % 44, n16 = tn * 64 + 16 * chunk; r.n0 = tn * 64; r.k0 = tk * 64; r.dst = WSP(bf16_t, layer ? WS_WD1 : WS_WD0); r.Kdst = DFF; r.ld = DM;
          r.sp = q->w_down + (size_t)layer * DFF * DM + n16; return r; }
        i -= T_D;
      }
      if (i < T_IN) { const int tn = i / 16, tk = i % 16, n16 = tn * 64 + 16 * chunk; r.n0 = tn * 64; r.k0 = tk * 64; r.dst = WSP(bf16_t, WS_WIN); r.Kdst = DM; r.ld = 3 * DM;
        if (n16 < 2048) r.sp = q->conv_w_in + ((n16 & 128) ? 2048 : 1024) + (n16 >> 8) * 128 + (n16 & 127); else r.sp = q->conv_w_in + (n16 - 2048); return r; }
      i -= T_IN;
      { const int tn = i / 16, tk = i % 16, n16 = tn * 64 + 16 * chunk; r.n0 = tn * 64; r.k0 = tk * 64; r.dst = WSP(bf16_t, WS_WOUT); r.Kdst = DM; r.ld = DM; r.sp = q->conv_w_out + n16; return r; }
    };
    auto load2 = [&](const TItem& I, f32x4& v0, f32x4& v1) { v0 = (f32x4){0.f, 0.f, 0.f, 0.f}; v1 = v0;
      if (I.sp) { v0 = *(const f32x4*)(I.sp + (size_t)(I.k0 + (t >> 4)) * I.ld + cc); v1 = *(const f32x4*)(I.sp + (size_t)(I.k0 + (t >> 4) + 32) * I.ld + cc); } };
    int it = bid;
    if (it < T_TOTAL) {
      TItem cur = decode(it); f32x4 v0, v1; load2(cur, v0, v1);
      for (;;) {
        const int nit = it + G; const bool has = nit < T_TOTAL; TItem nxt = cur; f32x4 n0v = v0, n1v = v1;
        if (has) { nxt = decode(nit); load2(nxt, n0v, n1v); }
        { float* lp = lds_f + (t >> 4) * 65 + chunk * 16 + cc; lp[0] = v0[0]; lp[1] = v0[1]; lp[2] = v0[2]; lp[3] = v0[3];
          lp += 32 * 65; lp[0] = v1[0]; lp[1] = v1[1]; lp[2] = v1[2]; lp[3] = v1[3]; }
        __syncthreads();
        { const int n = t >> 3, kk = (t & 7) * 8; float a[8];
#pragma unroll
          for (int j = 0; j < 8; ++j) a[j] = lds_f[(kk + j) * 65 + n];
          u32x4 w; w.x = pk_bf16(a[0], a[1]); w.y = pk_bf16(a[2], a[3]); w.z = pk_bf16(a[4], a[5]); w.w = pk_bf16(a[6], a[7]);
          *(u32x4*)(cur.dst + (size_t)(cur.n0 + n) * cur.Kdst + cur.k0 + kk) = w; }
        __syncthreads();
        if (!has) break;
        cur = nxt; v0 = n0v; v1 = n1v; it = nit;
      }
    }
  }
  const int gt = bid * 512 + tid, nthr = G * 512;
  { const float* w_ukv = q->w_ukv; const float* w_uq = q->w_uq; bf16_t* Wuq = WSP(bf16_t, WS_WUQ);
  for (int idx = gt; idx < 1536 * 32; idx += nthr) {
    const int n = idx >> 5, jg = (idx & 31) * 8, h = n / 192, c = n % 192; float a[8];
#pragma unroll
    for (int i = 0; i < 8; ++i) a[i] = 0.f;
    if (c < 128) { const float* kr = w_ukv + (size_t)c * 2048 + h * 256;
      for (int d = 0; d < 128; d += 4) { const f32x4 kv = *(const f32x4*)(kr + d);
#pragma unroll
        for (int i = 0; i < 8; ++i) { const f32x4 qv = *(const f32x4*)(w_uq + (size_t)(jg + i) * 1536 + h * 192 + d); a[i] += qv[0] * kv[0] + qv[1] * kv[1] + qv[2] * kv[2] + qv[3] * kv[3]; } }
    } else {
#pragma unroll
      for (int i = 0; i < 8; ++i) a[i] = w_uq[(size_t)(jg + i) * 1536 + n];
    }
    u32x4 w; w.x = pk_bf16(a[0], a[1]); w.y = pk_bf16(a[2], a[3]); w.z = pk_bf16(a[4], a[5]); w.w = pk_bf16(a[6], a[7]);
    *(u32x4*)(Wuq + (size_t)n * 256 + jg) = w;
  } }
  { const float* w_ukv = q->w_ukv; const float* w_o = q->w_o; bf16_t* Wo = WSP(bf16_t, WS_WO);
  for (int idx = gt; idx < 1024 * 128; idx += nthr) {
    const int n = idx & 1023, kg = __builtin_amdgcn_readfirstlane(idx >> 10), h = kg >> 4, c0 = (kg & 15) * 8; float a[8];
#pragma unroll
    for (int i = 0; i < 8; ++i) a[i] = 0.f;
    const float* wop = w_o + (size_t)(h * 128) * DM + n; const float* vr = w_ukv + (size_t)c0 * 2048 + h * 256 + 128;
    for (int d = 0; d < 128; ++d) { const float wv = wop[(size_t)d * DM];
#pragma unroll
      for (int i = 0; i < 8; ++i) a[i] += vr[(size_t)i * 2048 + d] * wv; }
    u32x4 w; w.x = pk_bf16(a[0], a[1]); w.y = pk_bf16(a[2], a[3]); w.z = pk_bf16(a[4], a[5]); w.w = pk_bf16(a[6], a[7]);
    *(u32x4*)(Wo + (size_t)n * DM + h * 128 + c0) = w;
  } }
}

__device__ __forceinline__ void phase_qkv_post(int wsg) {
  ParamsK q = kparams();
  const int tid = opaque_tid(wsg), lane = tid & 63, wid = tid >> 6;
  const int wv = blockIdx.x * 8 + wid, nw = gridDim.x * 8;
  const bf16_t* QKVA = WSP(bf16_t, WS_QKVA); bf16_t* QAN = WSP(bf16_t, WS_QAN); bf16_t* KV = WSP(bf16_t, WS_KV);
  const f32x4 qn = *(const f32x4*)(q->q_norm + lane * 4);
  const float kn0 = q->kv_norm[lane * 2], kn1 = q->kv_norm[lane * 2 + 1];
  const float frev = rope_freq_rev(lane & 15);
  for (int row = wv; row < MALL; row += nw) {
    const bf16_t* rp = QKVA + (size_t)row * 512;
    const u32x2 qa = *(const u32x2*)(rp + lane * 4); const unsigned ka = *(const unsigned*)(rp + 256 + lane * 2); const float kr = bf_lo((unsigned)rp[384 + lane]);
    const float q0 = bf_lo(qa.x), q1 = bf_hi(qa.x), q2 = bf_lo(qa.y), q3 = bf_hi(qa.y), k0 = bf_lo(ka), k1 = bf_hi(ka);
    const float qss = wave_sum(q0 * q0 + q1 * q1 + q2 * q2 + q3 * q3), kss = wave_sum(k0 * k0 + k1 * k1);
    const float qr = rsqrtf(qss * (1.0f / 256.0f) + NORM_EPS), krs = rsqrtf(kss * (1.0f / 128.0f) + NORM_EPS);
    size_t kvrow; float kro = kr;
    if (row < MLAT) { const int b = row / SEQ, t = row % SEQ; kvrow = (size_t)b * SKV + CTX + t;
      u32x2 o; o.x = pk_bf16(q0 * qr * qn[0], q1 * qr * qn[1]); o.y = pk_bf16(q2 * qr * qn[2], q3 * qr * qn[3]);
      *(u32x2*)(QAN + (size_t)row * 256 + lane * 4) = o;
      const float pos = (float)(lane < 32 ? (t >> 6) : (t & 63)); float s, c; sincos_rev(pos * frev, s, c);
      const float xp = __shfl_xor(kr, 16);
      kro = (lane & 16) ? kr * c + xp * s : kr * c - xp * s;
    } else { const int r2 = row - MLAT; kvrow = (size_t)(r2 / CTX) * SKV + (r2 % CTX); }
    bf16_t* kp = KV + kvrow * DQK;
    *(unsigned*)(kp + lane * 2) = pk_bf16(k0 * krs * kn0, k1 * krs * kn1);
    kp[128 + lane] = (bf16_t)(pk_bf16(kro, 0.f) & 0xffffu);
  }
}

__device__ __forceinline__ void phase_attn(int wsg, unsigned char* shm) {
  ParamsK q = kparams();
  const bf16_t* Qb = WSP(bf16_t, WS_Q); const bf16_t* KV = WSP(bf16_t, WS_KV); bf16_t* Ob = WSP(bf16_t, WS_O);
  for (int u = blockIdx.x; u < NB * NH * (SEQ / 256); u += gridDim.x) {
    const int w = u & 255, r = u >> 8, xcd = w & 7, slot = w >> 3;
    const int b = xcd >> 1, idx = (xcd & 1) * 128 + r * 32 + slot, h = idx >> 5, qb = idx & 31;
    __syncthreads();
    att::attn_unit(wsg, Qb + ((size_t)(b * SEQ + qb * 256) * 1536 + h * DQK), KV + (size_t)b * SKV * DQK, Ob + ((size_t)(b * SEQ + qb * 256) * DM + h * 128), (LAS unsigned char*)shm);
  }
}

__device__ __forceinline__ void phase_conv(int wsg) {
  ParamsK q = kparams();
  const int tid = opaque_tid(wsg);
  const bf16_t* CV = WSP(bf16_t, WS_CV); const bf16_t* BG = WSP(bf16_t, WS_BG); bf16_t* Z = WSP(bf16_t, WS_Z);
  const float* cw = q->conv_w;
  const size_t nitem = (size_t)MLAT * DM / 8;
  for (size_t it = (size_t)blockIdx.x * 512 + tid; it < nitem; it += (size_t)gridDim.x * 512) {
    const int row = (int)(it >> 7), d0 = (int)(it & 127) * 8, t = row & (SEQ - 1);
    const u32x4 cur = *(const u32x4*)(CV + (size_t)row * DM + d0);
    u32x4 prv = (u32x4){0u, 0u, 0u, 0u}, nxt = (u32x4){0u, 0u, 0u, 0u};
    if (t > 0) prv = *(const u32x4*)(CV + (size_t)(row - 1) * DM + d0);
    if (t < SEQ - 1) nxt = *(const u32x4*)(CV + (size_t)(row + 1) * DM + d0);
    const u32x4 bg = *(const u32x4*)(BG + (size_t)row * DM + d0);
    const float* w0 = cw + d0; const float* w1 = cw + DM + d0; const float* w2 = cw + 2 * DM + d0;
    u32x4 o;
#pragma unroll
    for (int k = 0; k < 4; ++k) {
      const float ul = w0[2 * k] * bf_lo(prv[k]) + w1[2 * k] * bf_lo(cur[k]) + w2[2 * k] * bf_lo(nxt[k]);
      const float uh = w0[2 * k + 1] * bf_hi(prv[k]) + w1[2 * k + 1] * bf_hi(cur[k]) + w2[2 * k + 1] * bf_hi(nxt[k]);
      o[k] = pk_bf16(bf_lo(bg[k]) * ul, bf_hi(bg[k]) * uh); }
    *(u32x4*)(Z + (size_t)row * DM + d0) = o;
  }
}

#define GEMM_SETUP(M_, N_) ParamsK q = kparams(); pg8::StaticOrder S; S.init((M_), (N_), gridDim.x, blockIdx.x); LAS unsigned char* ldsl = (LAS unsigned char*)shm
__device__ __forceinline__ void phase_gemm_qkva(int wsg, unsigned char* shm) { GEMM_SETUP(MALL, 512);
  pg8::Gemm g{WSP(bf16_t, WS_H), WSP(bf16_t, WS_WQKVA), MALL, 512, DM}; pg8::EpiBf16 E{WSP(bf16_t, WS_QKVA), 512}; pg8::gemm_phase(wsg, ldsl, g, S, E); }
__device__ __forceinline__ void phase_gemm_uq(int wsg, unsigned char* shm) { GEMM_SETUP(MLAT, 1536);
  pg8::Gemm g{WSP(bf16_t, WS_QAN), WSP(bf16_t, WS_WUQ), MLAT, 1536, 256}; pg8::EpiQRope E{WSP(bf16_t, WS_Q)}; pg8::gemm_phase(wsg, ldsl, g, S, E); }
__device__ __forceinline__ void phase_gemm_mixout0(int wsg, unsigned char* shm) { GEMM_SETUP(MLAT, DM);
  pg8::Gemm g{WSP(bf16_t, WS_O), WSP(bf16_t, WS_WO), MLAT, DM, DM};
  pg8::EpiResid<true> E{q->x, WSP(bf16_t, WS_X16), WSP(float, WS_MOD) + 2048}; pg8::gemm_phase(wsg, ldsl, g, S, E); }
__device__ __forceinline__ void phase_gemm_mixout1(int wsg, unsigned char* shm) { GEMM_SETUP(MLAT, DM);
  pg8::Gemm g{WSP(bf16_t, WS_Z), WSP(bf16_t, WS_WOUT), MLAT, DM, DM};
  pg8::EpiResid<false> E{WSP(bf16_t, WS_X16), WSP(bf16_t, WS_X16), WSP(float, WS_MOD) + (size_t)5 * 6144 + 2048}; pg8::gemm_phase(wsg, ldsl, g, S, E); }
__device__ __forceinline__ void phase_gemm_convin(int wsg, unsigned char* shm) { GEMM_SETUP(MLAT, 3 * DM);
  pg8::Gemm g{WSP(bf16_t, WS_H), WSP(bf16_t, WS_WIN), MLAT, 3 * DM, DM}; pg8::EpiConvIn E{WSP(bf16_t, WS_CV), WSP(bf16_t, WS_BG)}; pg8::gemm_phase(wsg, ldsl, g, S, E); }
__device__ __forceinline__ void phase_gemm_gu(int wsg, unsigned char* shm, int layer) { GEMM_SETUP(MLAT, 2 * DFF);
  pg8::Gemm g{WSP(bf16_t, WS_H), WSP(bf16_t, layer ? WS_WGU1 : WS_WGU0), MLAT, 2 * DFF, DM}; pg8::EpiSwiglu E{WSP(bf16_t, WS_G), DFF}; pg8::gemm_phase(wsg, ldsl, g, S, E); }
__device__ __forceinline__ void phase_gemm_down(int wsg, unsigned char* shm, int layer) { GEMM_SETUP(MLAT, DM);
  pg8::Gemm g{WSP(bf16_t, WS_G), WSP(bf16_t, layer ? WS_WD1 : WS_WD0), MLAT, DM, DFF};
  pg8::EpiResid<false> E{WSP(bf16_t, WS_X16), WSP(bf16_t, WS_X16), WSP(float, WS_MOD) + (size_t)layer * 5 * 6144 + 5120}; pg8::gemm_phase(wsg, ldsl, g, S, E); }

#define XB_TMO      128
#define XB_XCNT(j)  (256  + 64 * (j))
#define XB_XSUB(j)  (1280 + 64 * (j))
#define XB_XGEN(j)  (2304 + 64 * (j))
#define XB_TOP      3328
#define XB_TOPGEN   3392
#define XB_SPIN_CAP (1u << 20)
constexpr int LDS_XB = LDS_BYTES - 16;
__device__ __forceinline__ unsigned xb_ld(unsigned* p)              { return __hip_atomic_load(p, __ATOMIC_RELAXED, __HIP_MEMORY_SCOPE_AGENT); }
__device__ __forceinline__ unsigned xb_add(unsigned* p, unsigned v) { return __hip_atomic_fetch_add(p, v, __ATOMIC_RELAXED, __HIP_MEMORY_SCOPE_AGENT); }
__device__ __forceinline__ unsigned xb_xcc_id() { return (unsigned)__builtin_amdgcn_s_getreg((3 << 11) | 20) & 0xFu; }
#define XB_SPIN(cond, bar) do { unsigned _sp = 0; while (cond) { __builtin_amdgcn_s_sleep(1); \
    if ((++_sp & 255u) == 0u) { if (xb_ld(&(bar)[XB_TMO])) break; if (_sp > XB_SPIN_CAP) { atomicAdd(&(bar)[XB_TMO], 1u); break; } } } } while (0)
__device__ __forceinline__ void xcd_barrier_complete(unsigned* bar, unsigned x, unsigned& nloc, unsigned& nx) {
  const unsigned G = gridDim.x;
  unsigned sum, cnt, mine, sp = 0u;
  for (;;) {
    sum = 0u; cnt = 0u; mine = 0u;
#pragma unroll
    for (unsigned j = 0; j < 16; ++j) { const unsigned c = xb_ld(&bar[XB_XCNT(j)]); sum += c; cnt += (c > 0u) ? 1u : 0u; mine = (j == x) ? c : mine; }
    if (sum == G) break;
    __builtin_amdgcn_s_sleep(1);
    if ((++sp & 255u) == 0u) { if (xb_ld(&bar[XB_TMO])) break; if (sp > XB_SPIN_CAP) { atomicAdd(&bar[XB_TMO], 1u); break; } }
  }
  nloc = mine > 0u ? mine : 1u; nx = cnt > 0u ? cnt : 1u;
}
__device__ __forceinline__ void grid_bar_post(int wsg, unsigned char* shm) {
  ParamsK q = kparams(); unsigned* bar = (unsigned*)q->ws; const unsigned x = xb_xcc_id();
  if (opaque_tid(wsg) == 0) { volatile LAS unsigned* st = (volatile LAS unsigned*)((LAS unsigned char*)shm + LDS_XB); st[0] = 0u; st[1] = 0u;
    (void)xb_add(&bar[XB_XCNT(x)], 1u); }
  __syncthreads();
}
__device__ __forceinline__ void grid_bar(int wsg, unsigned char* shm) {
  asm volatile("s_waitcnt vmcnt(0)" ::: "memory");
  __syncthreads();
  ParamsK q = kparams(); unsigned* bar = (unsigned*)q->ws; const unsigned x = xb_xcc_id();
  if (opaque_tid(wsg) == 0) {
    volatile LAS unsigned* st = (volatile LAS unsigned*)((LAS unsigned char*)shm + LDS_XB);
    __builtin_amdgcn_s_waitcnt(0);
    unsigned nloc = st[0], nx = st[1];
    if (nloc == 0u) { xcd_barrier_complete(bar, x, nloc, nx); st[0] = nloc; st[1] = nx; }
    const unsigned old = xb_add(&bar[XB_XSUB(x)], 1u);
    const unsigned gen = old / nloc;
    if (old + 1u == (gen + 1u) * nloc) {
      __builtin_amdgcn_fence(__ATOMIC_RELEASE, "agent");
      asm volatile("s_waitcnt vmcnt(0)" ::: "memory");
      const unsigned og = xb_add(&bar[XB_TOP], 1u);
      const unsigned tg = og / nx;
      if (og + 1u == (tg + 1u) * nx) xb_add(&bar[XB_TOPGEN], 1u);
      else XB_SPIN(xb_ld(&bar[XB_TOPGEN]) == tg, bar);
      __builtin_amdgcn_fence(__ATOMIC_ACQUIRE, "agent");
      xb_add(&bar[XB_XGEN(x)], 1u);
      asm volatile("s_waitcnt vmcnt(0)" ::: "memory");
    } else {
      XB_SPIN(xb_ld(&bar[XB_XGEN(x)]) == gen, bar);
      __builtin_amdgcn_fence(__ATOMIC_ACQUIRE, "agent");
      asm volatile("s_waitcnt vmcnt(0)" ::: "memory");
    }
  }
  __syncthreads();
}


__device__ __forceinline__ void phase_norm_mix0(int wsg) { ParamsK q = kparams();
  norm_rows<false, false>(wsg, q->x, q->ctx, nullptr, MALL, q->norm_mix, WSP(float, WS_MOD), 0, 1024, WSP(bf16_t, WS_H), nullptr); }
__device__ __forceinline__ void phase_norm_mix1(int wsg) { ParamsK q = kparams();
  norm_rows<false, true>(wsg, nullptr, nullptr, WSP(bf16_t, WS_X16), MLAT, q->norm_mix + DM, WSP(float, WS_MOD) + (size_t)5 * 6144, 0, 1024, WSP(bf16_t, WS_H), nullptr); }
template <int LAYER> __device__ __forceinline__ void phase_norm_ffn(int wsg) { ParamsK q = kparams();
  norm_rows<false, true>(wsg, nullptr, nullptr, WSP(bf16_t, WS_X16), MLAT, q->norm_ffn + LAYER * DM, WSP(float, WS_MOD) + (size_t)LAYER * 5 * 6144, 3072, 4096, WSP(bf16_t, WS_H), nullptr); }

__global__ void __launch_bounds__(512, 2) mk_fwd(Params p) {
  extern __shared__ __attribute__((aligned(16))) unsigned char shm[];
  cg::grid_group grid = cg::this_grid();
  const int wsg = __builtin_amdgcn_readfirstlane((int)(threadIdx.x >> 6));
  grid_bar_post(wsg, shm);
  phase_adaln(wsg, shm);
  grid.sync();
  phase_norm_mix0(wsg); phase_prologue(wsg, shm); grid_bar(wsg, shm);
  phase_gemm_qkva(wsg, shm); grid_bar(wsg, shm);
  phase_qkv_post(wsg); grid_bar(wsg, shm);
  phase_gemm_uq(wsg, shm); grid_bar(wsg, shm);
  phase_attn(wsg, shm); grid_bar(wsg, shm);
  phase_gemm_mixout0(wsg, shm); grid_bar(wsg, shm);
  phase_norm_ffn<0>(wsg); grid_bar(wsg, shm);
  phase_gemm_gu(wsg, shm, 0); grid_bar(wsg, shm);
  phase_gemm_down(wsg, shm, 0); grid_bar(wsg, shm);
  phase_norm_mix1(wsg); grid_bar(wsg, shm);
  phase_gemm_convin(wsg, shm); grid_bar(wsg, shm);
  phase_conv(wsg); grid_bar(wsg, shm);
  phase_gemm_mixout1(wsg, shm); grid_bar(wsg, shm);
  phase_norm_ffn<1>(wsg); grid_bar(wsg, shm);
  phase_gemm_gu(wsg, shm, 1); grid_bar(wsg, shm);
  phase_gemm_down(wsg, shm, 1); grid_bar(wsg, shm);
  { ParamsK q = kparams(); norm_rows<true, true>(wsg, nullptr, nullptr, WSP(bf16_t, WS_X16), MLAT, q->final_norm, nullptr, 0, 0, nullptr, q->out); }
}

extern "C" void kernel_launch(void* const* d_in, const int* in_sizes, int n_in, void* d_out, int out_size, void* d_ws, size_t ws_size, hipStream_t stream) {
  static int grid_blocks = 0;
  if (!grid_blocks) {
    if (ws_size < WS_END) { fprintf(stderr, "kernel_launch: ws too small %zu < %zu\n", ws_size, (size_t)WS_END); return; }
    if (hipFuncSetAttribute((const void*)mk_fwd, hipFuncAttributeMaxDynamicSharedMemorySize, LDS_BYTES) != hipSuccess) { fprintf(stderr, "kernel_launch: set LDS attr failed\n"); return; }
    int dev = 0, cus = 0, per_cu = 0;
    (void)hipGetDevice(&dev);
    (void)hipDeviceGetAttribute(&cus, hipDeviceAttributeMultiprocessorCount, dev);
    (void)hipOccupancyMaxActiveBlocksPerMultiprocessor(&per_cu, mk_fwd, 512, LDS_BYTES);
    if (per_cu < 1) { fprintf(stderr, "kernel_launch: occupancy 0\n"); return; }
    grid_blocks = cus;
  }
  Params p{};
  p.x = (const float*)d_in[0]; p.c = (const float*)d_in[1]; p.ctx = (const float*)d_in[2]; p.c_ctx = (const float*)d_in[3];
  p.ada_w = (const float*)d_in[4]; p.ada_b = (const float*)d_in[5]; p.norm_mix = (const float*)d_in[6]; p.norm_ffn = (const float*)d_in[7];
  p.w_dq = (const float*)d_in[8]; p.q_norm = (const float*)d_in[9]; p.w_uq = (const float*)d_in[10]; p.w_dkv = (const float*)d_in[11];
  p.kv_norm = (const float*)d_in[12]; p.w_ukv = (const float*)d_in[13]; p.w_o = (const float*)d_in[14];
  p.conv_w_in = (const float*)d_in[15]; p.conv_w = (const float*)d_in[16]; p.conv_w_out = (const float*)d_in[17];
  p.w_gate = (const float*)d_in[18]; p.w_up = (const float*)d_in[19]; p.w_down = (const float*)d_in[20]; p.final_norm = (const float*)d_in[21];
  p.out = (float*)d_out; p.ws = (unsigned char*)d_ws;
  void* args[] = {&p};
  (void)hipMemsetAsync(d_ws, 0, 16384, stream);
  hipError_t e = hipLaunchCooperativeKernel((void*)mk_fwd, dim3(grid_blocks), dim3(512), args, LDS_BYTES, stream);
  if (e != hipSuccess) fprintf(stderr, "cooperative launch failed: %s (grid %d)\n", hipGetErrorString(e), grid_blocks);
}
```

```cpp
#include <hip/hip_runtime.h>
#include <hip/hip_cooperative_groups.h>
#include <cstdio>
#include <cstdint>
namespace cg = cooperative_groups;

typedef unsigned short bf16_t;
typedef short bf16x8 __attribute__((ext_vector_type(8)));
typedef short s16x4 __attribute__((ext_vector_type(4)));
typedef float f32x4 __attribute__((ext_vector_type(4)));
typedef float f32x16 __attribute__((ext_vector_type(16)));
typedef unsigned u32x4 __attribute__((ext_vector_type(4)));
typedef unsigned u32x2 __attribute__((ext_vector_type(2)));
#define LAS __attribute__((address_space(3)))

constexpr int DM = 1024, NB = 4, SEQ = 8192, CTX = 256, NH = 8, DFF = 2816;
constexpr int MLAT = NB * SEQ;
constexpr int MCTX = NB * CTX;
constexpr int MALL = MLAT + MCTX;
constexpr int SKV = CTX + SEQ;
constexpr int DQK = 192;
constexpr float NORM_EPS = 1e-6f;

constexpr size_t MiB = 1u << 20;
constexpr size_t WS_MOD = 1 * MiB;
constexpr size_t WS_WQKVA = 2 * MiB;
constexpr size_t WS_WUQ = 3 * MiB;
constexpr size_t WS_WO = 4 * MiB;
constexpr size_t WS_WGU0 = 6 * MiB;
constexpr size_t WS_WD0 = 17 * MiB;
constexpr size_t WS_WIN = 23 * MiB;
constexpr size_t WS_WOUT = 29 * MiB;
constexpr size_t WS_WGU1 = 31 * MiB;
constexpr size_t WS_WD1 = 42 * MiB;
constexpr size_t WS_H = 48 * MiB;
constexpr size_t WS_BIG = 116 * MiB;
constexpr size_t WS_QKVA = WS_BIG;
constexpr size_t WS_QAN = WS_BIG + 33 * MiB;
constexpr size_t WS_KV = WS_BIG + 49 * MiB;
constexpr size_t WS_Q = WS_BIG + 64 * MiB;
constexpr size_t WS_O = WS_BIG + 160 * MiB;
constexpr size_t WS_G = WS_BIG;
constexpr size_t WS_CV = WS_BIG;
constexpr size_t WS_BG = WS_BIG + 64 * MiB;
constexpr size_t WS_Z = WS_BIG + 128 * MiB;
constexpr size_t WS_X16 = WS_BIG + 224 * MiB;
constexpr size_t WS_END = WS_BIG + 288 * MiB;
static_assert(WS_KV + (size_t)NB * SKV * DQK * 2 <= WS_Q && WS_QAN + (size_t)MLAT * 256 * 2 <= WS_KV && WS_QKVA + (size_t)MALL * 512 * 2 <= WS_QAN && WS_Q + (size_t)MLAT * 1536 * 2 <= WS_O && WS_O + (size_t)MLAT * DM * 2 <= WS_END && WS_G + (size_t)MLAT * DFF * 2 <= WS_END && WS_H + (size_t)MALL * DM * 2 <= WS_BIG, "ws map");

constexpr int LDS_BYTES = 163840;

typedef float f32x2_t __attribute__((ext_vector_type(2)));
typedef __bf16 bf16x2_t __attribute__((ext_vector_type(2)));
__device__ __forceinline__ unsigned pk_bf16(float lo, float hi) { const f32x2_t v = {lo, hi}; const bf16x2_t b = __builtin_convertvector(v, bf16x2_t); return __builtin_bit_cast(unsigned, b); }
__device__ __forceinline__ float bf_lo(unsigned u) { return __uint_as_float(u << 16); }
__device__ __forceinline__ float bf_hi(unsigned u) { return __uint_as_float(u & 0xffff0000u); }
__device__ __forceinline__ float wave_sum(float v) {
#pragma unroll
  for (int o = 32; o >= 1; o >>= 1) v += __shfl_xor(v, o);
  return v;
}
__device__ __forceinline__ int opaque_tid(int wsg) { int t; asm volatile("v_mbcnt_lo_u32_b32 %0, -1, 0\n\tv_mbcnt_hi_u32_b32 %0, -1, %0\n\tv_lshl_or_b32 %0, %1, 6, %0" : "=&v"(t) : "s"(wsg)); return t; }
__device__ __forceinline__ float silu_f(float x) { return x / (1.0f + __expf(-x)); }
__device__ __forceinline__ float rope_freq_rev(int i) { return __builtin_amdgcn_exp2f(-(float)i * (13.287712379549449f / 16.0f)) * 0.15915494309189535f; }
__device__ __forceinline__ void sincos_rev(float rev, float& s, float& c) { float f = rev - floorf(rev); s = __builtin_amdgcn_sinf(f); c = __builtin_amdgcn_cosf(f); }

namespace pg8 {
constexpr int BM = 256, BK = 64, HALF = 128, HTB = HALF * BK * 2, STAGE_BYTES = 8 * HTB, NXCD = 8, WGM = 8;
__device__ __forceinline__ int lds_byte(int r, int c) { const int st = (r >> 4) * 2 + (c >> 5), rr = r & 15, cc = c & 31, ob = rr * 64 + cc * 2; return st * 1024 + (ob ^ (((ob >> 9) & 1) << 5)); }
__device__ __forceinline__ void stage_rc(int b, int& R, int& C) { const int st = b / 1024, sb = b % 1024, swz = sb ^ (((sb >> 9) & 1) << 5); R = (st >> 1) * 16 + swz / 64; C = (st & 1) * 32 + (swz % 64) / 2; }
__device__ __forceinline__ int perm32(int rho) { const int n = rho >> 4, i = rho & 15; return 8 * (i >> 2) + 4 * n + (i & 3); }
struct Unit { int pm, pn; };
struct Gemm { const bf16_t* A; const bf16_t* Bt; int M, N, K; };
struct StaticOrder {
  int nM, nN, nwg, G, c;
  __device__ void init(int M, int N, int G_, int c_) { nM = M / BM; nN = N / BM; nwg = nM * nN; G = G_; c = c_; }
  __device__ bool next(int i, Unit& u) const {
    const long L = (long)i * G + c; if (L >= nwg) return false;
    int wgid = (int)L; { const int q = nwg / NXCD, r = nwg % NXCD, xcd = wgid % NXCD, off = wgid / NXCD; wgid = (xcd < r ? xcd * (q + 1) : r * (q + 1) + (xcd - r) * q) + off; }
    const int nig = WGM * nN, gid = wgid / nig, fm = gid * WGM, gsz = (nM - fm) < WGM ? (nM - fm) : WGM;
    u.pm = fm + ((wgid % nig) % gsz); u.pn = (wgid % nig) / gsz; return true;
  }
};

template <class Epi>
__device__ __forceinline__ void gemm_phase(int wsg, LAS unsigned char* lds, const Gemm g, const StaticOrder& S, const Epi& E) {
  const int tid = opaque_tid(wsg), wid = __builtin_amdgcn_readfirstlane(tid >> 6), lane = tid & 63, wr = wid >> 2, wc = wid & 3, fr = lane & 15, fq = lane >> 4;
  const int K = g.K, nt = K / BK;
  unsigned voffA[2], voffB[2];
#pragma unroll
  for (int i = 0; i < 2; ++i) { int R, C; stage_rc(tid * 16 + i * 8192, R, C); const int Rb = Epi::PERM ? ((R & ~31) + perm32(R & 31)) : R;
    voffA[i] = (unsigned)(R * K + C) * 2u; voffB[i] = (unsigned)(Rb * K + C) * 2u; }
  const size_t kstep = (size_t)(BK * 2);
  const size_t hstep = (size_t)HALF * K * 2;
  const size_t tstep = 2 * hstep;
  const unsigned ldsw = (unsigned)wid * 1024u;
  const int aoff = lds_byte(wr * 64 + fr, fq * 8), boff = lds_byte(wc * 32 + fr, fq * 8);
#define PG8_SA(b, h) (((b) * 2 + (h)) * HTB)
#define PG8_SB(b, h) ((4 + (b) * 2 + (h)) * HTB)
#define PG8_STAGE(bufoff, gbase, voff) do { _Pragma("unroll") for (int _i = 0; _i < 2; ++_i) \
    __builtin_amdgcn_global_load_lds((const unsigned*)((const char*)(gbase) + (voff)[_i]), (LAS unsigned*)(lds + (bufoff) + ldsw + _i * 8192), 16, 0, 0); } while (0)
#define PG8_LDA(dst, b, h) do { _Pragma("unroll") for (int m = 0; m < 4; ++m) _Pragma("unroll") for (int k = 0; k < 2; ++k) dst[m][k] = *(const LAS bf16x8*)(lds + PG8_SA(b, h) + aoff + m * 2048 + k * 1024); } while (0)
#define PG8_LDB(dst, b, h) do { _Pragma("unroll") for (int n = 0; n < 2; ++n) _Pragma("unroll") for (int k = 0; k < 2; ++k) dst[n][k] = *(const LAS bf16x8*)(lds + PG8_SB(b, h) + boff + n * 2048 + k * 1024); } while (0)
#define PG8_MMA(ai, bj, At, Bt) do { __builtin_amdgcn_s_setprio(1); _Pragma("unroll") for (int m = 0; m < 4; ++m) _Pragma("unroll") for (int n = 0; n < 2; ++n) _Pragma("unroll") for (int k = 0; k < 2; ++k) \
    acc[ai][bj][m][n] = __builtin_amdgcn_mfma_f32_16x16x32_bf16(Bt[n][k], At[m][k], acc[ai][bj][m][n], 0, 0, 0); __builtin_amdgcn_s_setprio(0); } while (0)
#define PG8_WAIT_V(n) asm volatile("s_waitcnt vmcnt(" #n ")" ::: "memory")
#define PG8_WAIT_L(n) asm volatile("s_waitcnt lgkmcnt(" #n ")" ::: "memory")
#define PG8_BAR __builtin_amdgcn_s_barrier()
#define PG8_SCHED __builtin_amdgcn_sched_barrier(0)
  Unit cur, nxt; int ui = 0;
  if (!S.next(0, cur)) return;
  f32x4 acc[2][2][4][2];
#pragma unroll
  for (int a = 0; a < 2; ++a)
#pragma unroll
    for (int b = 0; b < 2; ++b)
#pragma unroll
      for (int m = 0; m < 4; ++m)
#pragma unroll
        for (int n = 0; n < 2; ++n) acc[a][b][m][n] = (f32x4){0.f, 0.f, 0.f, 0.f};
  bf16x8 At[4][2], B0[2][2], B1[2][2];
  const char* cA = (const char*)g.A + (size_t)cur.pm * tstep; const char* cB = (const char*)g.Bt + (size_t)cur.pn * tstep;
  PG8_STAGE(PG8_SB(0, 0), cB, voffB); PG8_STAGE(PG8_SA(0, 0), cA, voffA); PG8_STAGE(PG8_SB(0, 1), cB + hstep, voffB); PG8_STAGE(PG8_SA(0, 1), cA + hstep, voffA);
  if (wr == 1) PG8_BAR;
  PG8_WAIT_V(4); PG8_BAR;
  PG8_STAGE(PG8_SB(1, 0), cB + kstep, voffB); PG8_STAGE(PG8_SA(1, 0), cA + kstep, voffA); PG8_STAGE(PG8_SB(1, 1), cB + hstep + kstep, voffB);
  PG8_WAIT_V(6); PG8_BAR;
  for (;;) {
    const bool has_next = S.next(ui + 1, nxt);
    const char* nA = has_next ? (const char*)g.A + (size_t)nxt.pm * tstep : cA; const char* nB = has_next ? (const char*)g.Bt + (size_t)nxt.pn * tstep : cB;
    for (int t = 0; t < nt; t += 2) {
      const bool last = (t == nt - 2);
      const char* a1 = cA + (size_t)(t + 1) * kstep;
      const char* a2 = last ? nA : cA + (size_t)(t + 2) * kstep; const char* b2 = last ? nB : cB + (size_t)(t + 2) * kstep;
      const char* a3 = a2 + kstep; const char* b3 = b2 + kstep;
      PG8_LDB(B0, 0, 0); PG8_SCHED; PG8_LDA(At, 0, 0); PG8_STAGE(PG8_SA(1, 1), a1 + hstep, voffA);
      PG8_WAIT_L(8); PG8_BAR; PG8_WAIT_L(0); PG8_MMA(0, 0, At, B0); PG8_BAR; PG8_SCHED;
      PG8_LDB(B1, 0, 1); PG8_STAGE(PG8_SB(0, 0), b2, voffB);
      PG8_BAR; PG8_WAIT_L(0); PG8_MMA(0, 1, At, B1); PG8_BAR;
      PG8_LDA(At, 0, 1); PG8_STAGE(PG8_SA(0, 0), a2, voffA);
      PG8_BAR; PG8_WAIT_L(0); PG8_MMA(1, 0, At, B0); PG8_BAR; PG8_SCHED;
      PG8_STAGE(PG8_SB(0, 1), b2 + hstep, voffB);
      PG8_WAIT_V(6); PG8_BAR; PG8_MMA(1, 1, At, B1); PG8_BAR;
      PG8_LDB(B0, 1, 0); PG8_SCHED; PG8_LDA(At, 1, 0); PG8_STAGE(PG8_SA(0, 1), a2 + hstep, voffA);
      PG8_WAIT_L(8); PG8_BAR; PG8_WAIT_L(0); PG8_MMA(0, 0, At, B0); PG8_BAR; PG8_SCHED;
      PG8_LDB(B1, 1, 1); PG8_STAGE(PG8_SB(1, 0), b3, voffB);
      PG8_BAR; PG8_WAIT_L(0); PG8_MMA(0, 1, At, B1); PG8_BAR;
      PG8_LDA(At, 1, 1); PG8_STAGE(PG8_SA(1, 0), a3, voffA);
      PG8_BAR; PG8_WAIT_L(0); PG8_MMA(1, 0, At, B0); PG8_BAR; PG8_SCHED;
      PG8_STAGE(PG8_SB(1, 1), b3 + hstep, voffB);
      PG8_WAIT_V(6); PG8_BAR; PG8_MMA(1, 1, At, B1); PG8_BAR;
    }
    E(acc, cur, wr, wc, fr, fq);
    if (!has_next) break;
#pragma unroll
    for (int a = 0; a < 2; ++a)
#pragma unroll
      for (int b = 0; b < 2; ++b)
#pragma unroll
        for (int m = 0; m < 4; ++m)
#pragma unroll
          for (int n = 0; n < 2; ++n) acc[a][b][m][n] = (f32x4){0.f, 0.f, 0.f, 0.f};
    cur = nxt; cA = nA; cB = nB; ++ui;
  }
  PG8_WAIT_V(0);
  if (wr == 0) PG8_BAR;
  PG8_BAR;
#undef PG8_SA
#undef PG8_SB
#undef PG8_STAGE
#undef PG8_LDA
#undef PG8_LDB
#undef PG8_MMA
#undef PG8_WAIT_V
#undef PG8_WAIT_L
#undef PG8_BAR
#undef PG8_SCHED
}

struct EpiBf16 {
  static constexpr bool PERM = true;
  bf16_t* O; int ldc;
  __device__ __forceinline__ void operator()(const f32x4 (&acc)[2][2][4][2], const Unit& u, int wr, int wc, int fr, int fq) const {
    const int row0 = u.pm * BM + wr * 64 + fr, col0 = u.pn * BM + wc * 32 + 8 * fq;
#pragma unroll
    for (int ai = 0; ai < 2; ++ai)
#pragma unroll
      for (int m = 0; m < 4; ++m) { bf16_t* rowp = O + (size_t)(row0 + ai * HALF + m * 16) * ldc + col0;
#pragma unroll
        for (int bj = 0; bj < 2; ++bj) { const f32x4 v0 = acc[ai][bj][m][0], v1 = acc[ai][bj][m][1];
          u32x4 w; w.x = pk_bf16(v0[0], v0[1]); w.y = pk_bf16(v0[2], v0[3]); w.z = pk_bf16(v1[0], v1[1]); w.w = pk_bf16(v1[2], v1[3]);
          *(u32x4*)(rowp + bj * HALF) = w; } }
  }
};
struct EpiQRope {
  static constexpr bool PERM = false;
  bf16_t* O;
  __device__ __forceinline__ void operator()(const f32x4 (&acc)[2][2][4][2], const Unit& u, int wr, int wc, int fr, int fq) const {
    const int row0 = u.pm * BM + wr * 64 + fr;
    float fr_rev[4];
#pragma unroll
    for (int j = 0; j < 4; ++j) fr_rev[j] = rope_freq_rev(4 * fq + j);
#pragma unroll
    for (int bj = 0; bj < 2; ++bj) {
      const int gq = u.pn * 8 + bj * 4 + wc;
      const int within = gq % 6;
      const int col0 = gq * 32 + 4 * fq;
#pragma unroll
      for (int ai = 0; ai < 2; ++ai)
#pragma unroll
        for (int m = 0; m < 4; ++m) {
          const int row = row0 + ai * HALF + m * 16;
          f32x4 v0 = acc[ai][bj][m][0], v1 = acc[ai][bj][m][1];
          if (within >= 4) {
            const int t = row & (SEQ - 1);
            const float pos = (float)(within == 4 ? (t >> 6) : (t & 63));
#pragma unroll
            for (int j = 0; j < 4; ++j) { float s, c; sincos_rev(pos * fr_rev[j], s, c);
              const float x1 = v0[j], x2 = v1[j]; v0[j] = x1 * c - x2 * s; v1[j] = x2 * c + x1 * s; }
          }
          bf16_t* rowp = O + (size_t)row * 1536 + col0;
          u32x2 w0, w1; w0.x = pk_bf16(v0[0], v0[1]); w0.y = pk_bf16(v0[2], v0[3]); w1.x = pk_bf16(v1[0], v1[1]); w1.y = pk_bf16(v1[2], v1[3]);
          *(u32x2*)(rowp) = w0; *(u32x2*)(rowp + 16) = w1;
        }
    }
  }
};
template <bool XIN_F32>
struct EpiResid {
  static constexpr bool PERM = true;
  const void* xin; bf16_t* xout; const float* gate;
  __device__ __forceinline__ void operator()(const f32x4 (&acc)[2][2][4][2], const Unit& u, int wr, int wc, int fr, int fq) const {
    const int row0 = u.pm * BM + wr * 64 + fr, col0 = u.pn * BM + wc * 32 + 8 * fq;
    const float* gp = gate + (size_t)((u.pm * BM) / SEQ) * 6144 + col0;
    f32x4 gv[2][2];
#pragma unroll
    for (int bj = 0; bj < 2; ++bj)
#pragma unroll
      for (int n = 0; n < 2; ++n) gv[bj][n] = *(const f32x4*)(gp + bj * HALF + n * 4);
    f32x4 xa[2][2], xb[2][2];
#define EPR_LOAD(X, g) do { const size_t off_ = (size_t)(row0 + ((g) >> 2) * HALF + ((g) & 3) * 16) * DM + col0; \
      _Pragma("unroll") for (int bj = 0; bj < 2; ++bj) { \
        if (XIN_F32) { X[bj][0] = *(const f32x4*)((const float*)xin + off_ + bj * HALF); X[bj][1] = *(const f32x4*)((const float*)xin + off_ + bj * HALF + 4); } \
        else { const u32x4 t_ = *(const u32x4*)((const bf16_t*)xin + off_ + bj * HALF); X[bj][0] = (f32x4){bf_lo(t_.x), bf_hi(t_.x), bf_lo(t_.y), bf_hi(t_.y)}; X[bj][1] = (f32x4){bf_lo(t_.z), bf_hi(t_.z), bf_lo(t_.w), bf_hi(t_.w)}; } } } while (0)
#define EPR_STORE(X, g) do { const size_t off_ = (size_t)(row0 + ((g) >> 2) * HALF + ((g) & 3) * 16) * DM + col0; \
      _Pragma("unroll") for (int bj = 0; bj < 2; ++bj) { const f32x4 v0_ = X[bj][0] + gv[bj][0] * acc[(g) >> 2][bj][(g) & 3][0], v1_ = X[bj][1] + gv[bj][1] * acc[(g) >> 2][bj][(g) & 3][1]; \
        u32x4 w_; w_.x = pk_bf16(v0_[0], v0_[1]); w_.y = pk_bf16(v0_[2], v0_[3]); w_.z = pk_bf16(v1_[0], v1_[1]); w_.w = pk_bf16(v1_[2], v1_[3]); *(u32x4*)(xout + off_ + bj * HALF) = w_; } } while (0)
    EPR_LOAD(xa, 0); EPR_LOAD(xb, 1);
    EPR_STORE(xa, 0); EPR_LOAD(xa, 2); EPR_STORE(xb, 1); EPR_LOAD(xb, 3);
    EPR_STORE(xa, 2); EPR_LOAD(xa, 4); EPR_STORE(xb, 3); EPR_LOAD(xb, 5);
    EPR_STORE(xa, 4); EPR_LOAD(xa, 6); EPR_STORE(xb, 5); EPR_LOAD(xb, 7);
    EPR_STORE(xa, 6); EPR_STORE(xb, 7);
#undef EPR_LOAD
#undef EPR_STORE
  }
};
struct EpiSwiglu {
  static constexpr bool PERM = true;
  bf16_t* O; int ldc;
  __device__ __forceinline__ void operator()(const f32x4 (&acc)[2][2][4][2], const Unit& u, int wr, int wc, int fr, int fq) const {
    const int row0 = u.pm * BM + wr * 64 + fr, col0 = u.pn * HALF + wc * 32 + 8 * fq;
#pragma unroll
    for (int ai = 0; ai < 2; ++ai)
#pragma unroll
      for (int m = 0; m < 4; ++m) { float r[8];
#pragma unroll
        for (int n = 0; n < 2; ++n) { const f32x4 g = acc[ai][0][m][n], up = acc[ai][1][m][n];
#pragma unroll
          for (int j = 0; j < 4; ++j) r[4 * n + j] = g[j] * __builtin_amdgcn_rcpf(1.0f + __builtin_amdgcn_exp2f(-g[j] * 1.4426950408889634f)) * up[j]; }
        u32x4 w; w.x = pk_bf16(r[0], r[1]); w.y = pk_bf16(r[2], r[3]); w.z = pk_bf16(r[4], r[5]); w.w = pk_bf16(r[6], r[7]);
        *(u32x4*)(O + (size_t)(row0 + ai * HALF + m * 16) * ldc + col0) = w; }
  }
};
struct EpiConvIn {
  static constexpr bool PERM = true;
  bf16_t* CV; bf16_t* BG;
  __device__ __forceinline__ void operator()(const f32x4 (&acc)[2][2][4][2], const Unit& u, int wr, int wc, int fr, int fq) const {
    const int row0 = u.pm * BM + wr * 64 + fr;
#pragma unroll
    for (int ai = 0; ai < 2; ++ai)
#pragma unroll
      for (int m = 0; m < 4; ++m) { const size_t row = (size_t)(row0 + ai * HALF + m * 16);
        if (u.pn < 8) { const f32x4 r0 = acc[ai][0][m][0] * acc[ai][1][m][0], r1 = acc[ai][0][m][1] * acc[ai][1][m][1];
          u32x4 w; w.x = pk_bf16(r0[0], r0[1]); w.y = pk_bf16(r0[2], r0[3]); w.z = pk_bf16(r1[0], r1[1]); w.w = pk_bf16(r1[2], r1[3]);
          *(u32x4*)(CV + row * DM + u.pn * HALF + wc * 32 + 8 * fq) = w;
        } else {
#pragma unroll
          for (int bj = 0; bj < 2; ++bj) { const f32x4 a = acc[ai][bj][m][0], b = acc[ai][bj][m][1];
            u32x4 w; w.x = pk_bf16(a[0], a[1]); w.y = pk_bf16(a[2], a[3]); w.z = pk_bf16(b[0], b[1]); w.w = pk_bf16(b[2], b[3]);
            *(u32x4*)(BG + row * DM + (u.pn - 8) * BM + bj * HALF + wc * 32 + 8 * fq) = w; } } }
  }
};
}

namespace att {
constexpr int NW = 8, QBLK = 32, KVBLK = 64;
constexpr int LDQ = 1536, LDK = DQK, LDO = 1024;
constexpr float SCALE = 0.07216878364870322f;
constexpr float THR = 8.f;
constexpr int SHM_V = KVBLK * 128 * 2, SHM_K = KVBLK * DQK * 2;
constexpr int SHM_ATTN = 2 * SHM_V + 2 * SHM_K + NW * 64 * 4;
#define KSWZ(row, colB) ((row) * 384 + ((colB) ^ ((((row) >> 1) & 7) << 4)))
#define SBAR() __builtin_amdgcn_sched_barrier(0)
__device__ __forceinline__ int crow(int r, int hi) { return (r & 3) + 8 * (r >> 2) + 4 * hi; }
__device__ __forceinline__ unsigned cvtpk(float lo, float hi) { return pk_bf16(lo, hi); }

__device__ __forceinline__ void partialSM(f32x16& p0, f32x16& p1, float& m_reg, float& mn, float& alpha) {
  constexpr float C = SCALE * 1.4426950408889634f;
  float pmax = p0[0];
#pragma unroll
  for (int r = 1; r < 16; ++r) pmax = fmaxf(pmax, p0[r]);
#pragma unroll
  for (int r = 0; r < 16; ++r) pmax = fmaxf(pmax, p1[r]);
  { auto rr = __builtin_amdgcn_permlane32_swap(__float_as_uint(pmax), __float_as_uint(pmax), false, false);
    pmax = fmaxf(__uint_as_float(rr[0]), __uint_as_float(rr[1])); }
  if (__builtin_expect(__all(pmax - m_reg <= THR / SCALE), 1)) { mn = m_reg; alpha = 1.f; }
  else { mn = fmaxf(m_reg, pmax); alpha = __builtin_amdgcn_exp2f((m_reg - mn) * C); m_reg = mn; }
  float mnC = -mn * C;
#pragma unroll
  for (int r = 0; r < 16; ++r) p0[r] = fmaf(p0[r], C, mnC);
#pragma unroll
  for (int r = 0; r < 16; ++r) p1[r] = fmaf(p1[r], C, mnC);
#pragma unroll
  for (int r = 0; r < 16; ++r) p0[r] = __builtin_amdgcn_exp2f(p0[r]);
}
__device__ __forceinline__ void finishSM(f32x16& p0, f32x16& p1, float alpha, float& l_reg, bf16x8& pa0, bf16x8& pa1, bf16x8& pa2, bf16x8& pa3) {
#pragma unroll
  for (int r = 0; r < 16; ++r) p1[r] = __builtin_amdgcn_exp2f(p1[r]);
  float ps = 0;
#pragma unroll
  for (int r = 0; r < 16; ++r) ps += p0[r];
#pragma unroll
  for (int r = 0; r < 16; ++r) ps += p1[r];
  { auto rr = __builtin_amdgcn_permlane32_swap(__float_as_uint(ps), __float_as_uint(ps), false, false);
    ps = __uint_as_float(rr[0]) + __uint_as_float(rr[1]); }
  l_reg = l_reg * alpha + ps;
#define PK4(P, BASE, OUT) do { unsigned a0 = cvtpk(P[BASE + 0], P[BASE + 1]), a1 = cvtpk(P[BASE + 2], P[BASE + 3]);   \
    unsigned b0 = cvtpk(P[BASE + 4], P[BASE + 5]), b1 = cvtpk(P[BASE + 6], P[BASE + 7]);                              \
    auto r0 = __builtin_amdgcn_permlane32_swap(a0, b0, false, false); auto r1 = __builtin_amdgcn_permlane32_swap(a1, b1, false, false); \
    u32x4 w = {r0[0], r1[0], r0[1], r1[1]}; OUT = *reinterpret_cast<bf16x8*>(&w); } while (0)
  PK4(p0, 0, pa0); PK4(p0, 8, pa1); PK4(p1, 0, pa2); PK4(p1, 8, pa3);
#undef PK4
}
__device__ __forceinline__ void qkt(f32x16& p0, f32x16& p1, const char* Ks, const bf16x8* qr, int r32, int hi) {
  p0 = f32x16{}; p1 = f32x16{};
#pragma unroll
  for (int d0 = 0; d0 < 12; ++d0) { int cb = (d0 * 16 + hi * 8) * 2;
    bf16x8 b0 = *reinterpret_cast<const bf16x8*>(Ks + KSWZ(r32, cb));
    bf16x8 b1 = *reinterpret_cast<const bf16x8*>(Ks + KSWZ(32 + r32, cb));
    p0 = __builtin_amdgcn_mfma_f32_32x32x16_bf16(b0, qr[d0], p0, 0, 0, 0);
    p1 = __builtin_amdgcn_mfma_f32_32x32x16_bf16(b1, qr[d0], p1, 0, 0, 0);
    if ((d0 & 3) == 3 && d0 != 11) SBAR(); }
}
__device__ __forceinline__ int v_st(int k, int c) { const int kk = (k & ~0xC) | ((k & 4) << 1) | ((k & 8) >> 1); return ((kk >> 3) * 4 + (c >> 5)) * 512 + ((kk & 7) * 32 + (c & 31)) * 2; }
__device__ __forceinline__ int v_rd_base(int lane) { return ((lane & 3) << 3) | (((lane >> 2) & 3) << 6) | (((lane >> 4) & 1) << 5) | (((lane >> 5) & 1) << 8); }
constexpr int v_rd_off(int d0, int ks, int half) { return d0 * 512 + ks * 4096 + half * 2048; }
template <int OFF> __device__ __forceinline__ s16x4 tr_read(int vb) {
  s16x4 r; asm volatile("ds_read_b64_tr_b16 %0, %1 offset:%2" : "=&v"(r) : "v"(vb), "i"(OFF) : "memory"); return r;
}
template <int D0> __device__ __forceinline__ void pv_one(f32x16& od, int vb, bf16x8 pa0, bf16x8 pa1, bf16x8 pa2, bf16x8 pa3) {
  const s16x4 l0 = tr_read<v_rd_off(D0, 0, 0)>(vb), h0 = tr_read<v_rd_off(D0, 0, 1)>(vb), l1 = tr_read<v_rd_off(D0, 1, 0)>(vb), h1 = tr_read<v_rd_off(D0, 1, 1)>(vb);
  const s16x4 l2 = tr_read<v_rd_off(D0, 2, 0)>(vb), h2 = tr_read<v_rd_off(D0, 2, 1)>(vb), l3 = tr_read<v_rd_off(D0, 3, 0)>(vb), h3 = tr_read<v_rd_off(D0, 3, 1)>(vb);
  asm volatile("s_waitcnt lgkmcnt(0)" ::: "memory"); SBAR();
#define PK(L, H) (bf16x8){L[0], L[1], L[2], L[3], H[0], H[1], H[2], H[3]}
  od = __builtin_amdgcn_mfma_f32_32x32x16_bf16(pa0, PK(l0, h0), od, 0, 0, 0);
  od = __builtin_amdgcn_mfma_f32_32x32x16_bf16(pa1, PK(l1, h1), od, 0, 0, 0);
  od = __builtin_amdgcn_mfma_f32_32x32x16_bf16(pa2, PK(l2, h2), od, 0, 0, 0);
  od = __builtin_amdgcn_mfma_f32_32x32x16_bf16(pa3, PK(l3, h3), od, 0, 0, 0);
#undef PK
}
__device__ __forceinline__ void pv_d0(f32x16* o, int vb, bf16x8 pa0, bf16x8 pa1, bf16x8 pa2, bf16x8 pa3) {
  pv_one<0>(o[0], vb, pa0, pa1, pa2, pa3); pv_one<1>(o[1], vb, pa0, pa1, pa2, pa3); pv_one<2>(o[2], vb, pa0, pa1, pa2, pa3); pv_one<3>(o[3], vb, pa0, pa1, pa2, pa3);
}

constexpr int SLOT = SHM_K + SHM_V;
constexpr int NTILE = SKV / KVBLK;
static_assert(NTILE % 6 == 0, "tile loop is unrolled by 6");
constexpr int ATT_WS = 3 * SLOT;
__device__ __forceinline__ void attn_unit(int wsg, const bf16_t* __restrict__ Qb, const bf16_t* __restrict__ Kh, bf16_t* __restrict__ Ob, LAS unsigned char* ldsl) {
  const int tid = opaque_tid(wsg), wid = __builtin_amdgcn_readfirstlane(tid >> 6), lane = tid & 63, r32 = lane & 31, hi = lane >> 5;
  LAS float* ws = (LAS float*)(ldsl + ATT_WS) + wid * 64; LAS float* li_l = ws; LAS float* al_l = ws + 32;
  float m_reg = -1e30f, l_reg = 0; f32x16 o[4] = {}; bf16x8 qr[8];
  const bf16_t* Qw = Qb + (long)(wid * QBLK + r32) * LDQ + hi * 8;
#pragma unroll
  for (int d0 = 0; d0 < 8; ++d0) qr[d0] = *reinterpret_cast<const bf16x8*>(Qw + d0 * 16);
  LAS bf16x8* qlds = (LAS bf16x8*)(ldsl + ATT_WS + 2048 + wid * 4096) + lane;
#pragma unroll
  for (int i = 0; i < 4; ++i) qlds[i * 64] = *reinterpret_cast<const bf16x8*>(Qw + (8 + i) * 16);
  unsigned soff[5];
#pragma unroll
  for (int i = 0; i < 5; ++i) { const int ob = (wid * 5 + i) * 1024 + lane * 16;
    if (ob < SHM_K) { const int row = ob / 384, cph = ob % 384; soff[i] = (unsigned)(row * 384 + (cph ^ (((row >> 1) & 7) << 4))); }
    else { const int o2 = ob - SHM_K, st = o2 >> 9, wi = o2 & 511, kk = (st >> 2) * 8 + (wi >> 6), cc = (wi & 63) >> 1, cg = st & 3;
      const int k = (kk & ~0xC) | ((kk & 4) << 1) | ((kk & 8) >> 1); soff[i] = (unsigned)(k * 384 + (cg * 32 + cc) * 2); } }
  const int tsw = (hi * 16) ^ (((r32 >> 1) & 7) << 4);
  int kbs[4];
#pragma unroll
  for (int m = 0; m < 4; ++m) kbs[m] = r32 * 384 + ((m * 32) ^ tsw);
  const int vb0 = (int)(uintptr_t)(ldsl + SHM_K) + v_rd_base(lane);
#define ISSUE(SI, TI) do { const char* gb_ = (const char*)Kh + (size_t)(TI) * (KVBLK * 384); asm volatile("" : "+s"(gb_)); \
    _Pragma("unroll") for (int i_ = 0; i_ < 5; ++i_) __builtin_amdgcn_global_load_lds((const unsigned*)(gb_ + soff[i_]), (LAS unsigned*)(ldsl + (SI) * SLOT + (wid * 5 + i_) * 1024), 16, 0, 0); } while (0)
#define WAITBAR() asm volatile("s_waitcnt vmcnt(0) lgkmcnt(0)\n\ts_barrier" ::: "memory")
#define RESC(a) do { if (__any((a) < 1.f)) { if (hi == 0) al_l[r32] = (a); asm volatile("s_waitcnt lgkmcnt(0)" ::: "memory"); \
    _Pragma("unroll") for (int d = 0; d < 4; ++d) _Pragma("unroll") for (int r = 0; r < 16; ++r) o[d][r] *= al_l[crow(r, hi)]; } } while (0)
#define KLD(d0, SK, H) (*(const LAS bf16x8*)(ldsl + kbs[(d0) & 3] + ((SK) * SLOT + ((d0) >> 2) * 128 + (H) * (32 * 384))))
#define QKT(P0, P1, SK) do { P0 = f32x16{}; P1 = f32x16{}; \
    _Pragma("unroll") for (int d0 = 0; d0 < 12; ++d0) { \
      const bf16x8 b0_ = KLD(d0, SK, 0); const bf16x8 b1_ = KLD(d0, SK, 1); \
      bf16x8 qf_; if (d0 < 8) qf_ = qr[d0 < 8 ? d0 : 0]; else qf_ = qlds[(d0 - 8) * 64]; \
      P0 = __builtin_amdgcn_mfma_f32_32x32x16_bf16(b0_, qf_, P0, 0, 0, 0); \
      P1 = __builtin_amdgcn_mfma_f32_32x32x16_bf16(b1_, qf_, P1, 0, 0, 0); } } while (0)
#define QKT_SCHED() do { __builtin_amdgcn_sched_group_barrier(0x100, 2, 0); \
    _Pragma("unroll") for (int d0 = 0; d0 < 12; ++d0) { \
      __builtin_amdgcn_sched_group_barrier(0x008, 1, 0); __builtin_amdgcn_sched_group_barrier(0x400, 1, 0); __builtin_amdgcn_sched_group_barrier(0x002, 4, 0); \
      if (d0 < 7) __builtin_amdgcn_sched_group_barrier(0x100, 2, 0); else if (d0 < 11) __builtin_amdgcn_sched_group_barrier(0x100, 3, 0); \
      __builtin_amdgcn_sched_group_barrier(0x008, 1, 0); __builtin_amdgcn_sched_group_barrier(0x400, 1, 0); __builtin_amdgcn_sched_group_barrier(0x002, 4, 0); } } while (0)
#define PSM_A(P0, P1) do { pmax_ = P0[0]; _Pragma("unroll") for (int r = 1; r < 16; ++r) pmax_ = fmaxf(pmax_, P0[r]); _Pragma("unroll") for (int r = 0; r < 16; ++r) pmax_ = fmaxf(pmax_, P1[r]); } while (0)
#define PSM_B(P0, P1, MN, AL) do { constexpr float C_ = SCALE * 1.4426950408889634f; \
    { auto rr_ = __builtin_amdgcn_permlane32_swap(__float_as_uint(pmax_), __float_as_uint(pmax_), false, false); pmax_ = fmaxf(__uint_as_float(rr_[0]), __uint_as_float(rr_[1])); } \
    const bool keep_ = __all(pmax_ - m_reg <= THR / SCALE); const float mc_ = fmaxf(m_reg, pmax_); const float a2_ = __builtin_amdgcn_exp2f((m_reg - mc_) * C_); \
    MN = keep_ ? m_reg : mc_; AL = keep_ ? 1.f : a2_; m_reg = MN; mnC_ = -MN * C_; \
    _Pragma("unroll") for (int r = 0; r < 16; ++r) P0[r] = fmaf(P0[r], C_, mnC_); } while (0)
#define PSM_C(P0, P1) do { constexpr float C_ = SCALE * 1.4426950408889634f; \
    _Pragma("unroll") for (int r = 0; r < 16; ++r) P1[r] = fmaf(P1[r], C_, mnC_); \
    _Pragma("unroll") for (int r = 0; r < 4; ++r) P0[r] = __builtin_amdgcn_exp2f(P0[r]); } while (0)
#define PSM_D(P0) do { _Pragma("unroll") for (int r = 4; r < 16; ++r) P0[r] = __builtin_amdgcn_exp2f(P0[r]); } while (0)
#define HALF(PX0, PX1, MNX, ALX, PY0, PY1, ALY, SK, SV, SI, TI) do { \
    WAITBAR(); \
    if ((TI) < NTILE) ISSUE(SI, TI); \
    SBAR(); QKT(PX0, PX1, SK); \
    finishSM(PY0, PY1, ALY, l_reg, pa0, pa1, pa2, pa3); QKT_SCHED(); SBAR(); \
    { float pmax_, mnC_; const int vb_ = vb0 + (SV) * SLOT; \
      pv_one<0>(o[0], vb_, pa0, pa1, pa2, pa3); PSM_A(PX0, PX1); \
      pv_one<1>(o[1], vb_, pa0, pa1, pa2, pa3); PSM_B(PX0, PX1, MNX, ALX); \
      pv_one<2>(o[2], vb_, pa0, pa1, pa2, pa3); PSM_C(PX0, PX1); \
      pv_one<3>(o[3], vb_, pa0, pa1, pa2, pa3); PSM_D(PX0); asm volatile("" : "+v"(PX0), "+v"(PX1)); } \
    RESC(ALX); } while (0)
  f32x16 pA0, pA1, pB0, pB1; float mnA, mnB, alA, alB; bf16x8 pa0, pa1, pa2, pa3;
  ISSUE(0, 0); WAITBAR(); ISSUE(1, 1);
  QKT(pA0, pA1, 0); partialSM(pA0, pA1, m_reg, mnA, alA);
  for (int j = 1; j + 5 < NTILE; j += 6) {
    HALF(pB0, pB1, mnB, alB, pA0, pA1, alA, 1, 0, 2, j + 1);
    HALF(pA0, pA1, mnA, alA, pB0, pB1, alB, 2, 1, 0, j + 2);
    HALF(pB0, pB1, mnB, alB, pA0, pA1, alA, 0, 2, 1, j + 3);
    HALF(pA0, pA1, mnA, alA, pB0, pB1, alB, 1, 0, 2, j + 4);
    HALF(pB0, pB1, mnB, alB, pA0, pA1, alA, 2, 1, 0, j + 5);
    HALF(pA0, pA1, mnA, alA, pB0, pB1, alB, 0, 2, 1, j + 6);
  }
  HALF(pB0, pB1, mnB, alB, pA0, pA1, alA, 1, 0, 2, NTILE - 4);
  HALF(pA0, pA1, mnA, alA, pB0, pB1, alB, 2, 1, 0, NTILE - 3);
  HALF(pB0, pB1, mnB, alB, pA0, pA1, alA, 0, 2, 1, NTILE - 2);
  HALF(pA0, pA1, mnA, alA, pB0, pB1, alB, 1, 0, 2, NTILE - 1);
  HALF(pB0, pB1, mnB, alB, pA0, pA1, alA, 2, 1, 0, NTILE);
  finishSM(pB0, pB1, alB, l_reg, pa0, pa1, pa2, pa3); SBAR();
  pv_d0(o, vb0 + 2 * SLOT, pa0, pa1, pa2, pa3);
  if (hi == 0) li_l[r32] = l_reg; asm volatile("s_waitcnt lgkmcnt(0)" ::: "memory");
  bf16_t* Ow = Ob + (long)(wid * QBLK) * LDO;
#pragma unroll
  for (int r = 0; r < 16; ++r) { const int orow = crow(r, hi); const float rli = __builtin_amdgcn_rcpf(li_l[orow]);
#pragma unroll
    for (int d0 = 0; d0 < 4; ++d0) Ow[(long)orow * LDO + d0 * 32 + r32] = (bf16_t)(pk_bf16(o[d0][r] * rli, 0.f) & 0xffffu); }
#undef ISSUE
#undef WAITBAR
#undef RESC
#undef QKT
#undef PSM_A
#undef PSM_B
#undef PSM_C
#undef PSM_D
#undef QKT_SCHED
#undef KLD
#undef HALF
}
}

struct Params {
  const float* x; const float* c; const float* ctx; const float* c_ctx; const float* ada_w; const float* ada_b; const float* norm_mix; const float* norm_ffn;
  const float* w_dq; const float* q_norm; const float* w_uq; const float* w_dkv; const float* kv_norm; const float* w_ukv; const float* w_o;
  const float* conv_w_in; const float* conv_w; const float* conv_w_out; const float* w_gate; const float* w_up; const float* w_down; const float* final_norm;
  float* out; unsigned char* ws;
};

template <bool FINAL, bool SRC16>
__device__ __forceinline__ void norm_rows(int wsg, const float* src_lat, const float* src_ctx, const bf16_t* src16, int nrows, const float* w, const float* mod, int sh_off, int sc_off, bf16_t* H, float* outf) {
  const int tid_ = opaque_tid(wsg); const int lane = tid_ & 63, wv = blockIdx.x * 8 + (tid_ >> 6), nw = gridDim.x * 8;
  f32x4 wv4[4];
#pragma unroll
  for (int i = 0; i < 2; ++i) { wv4[2 * i] = *(const f32x4*)(w + i * 512 + lane * 8); wv4[2 * i + 1] = *(const f32x4*)(w + i * 512 + lane * 8 + 4); }
  for (int row = wv; row < nrows; row += nw) {
    f32x4 v[4]; float ss = 0.f;
    if (SRC16) { const bf16_t* xp = src16 + (size_t)row * DM;
#pragma unroll
      for (int i = 0; i < 2; ++i) { const u32x4 t = *(const u32x4*)(xp + i * 512 + lane * 8); v[2 * i] = (f32x4){bf_lo(t.x), bf_hi(t.x), bf_lo(t.y), bf_hi(t.y)}; v[2 * i + 1] = (f32x4){bf_lo(t.z), bf_hi(t.z), bf_lo(t.w), bf_hi(t.w)}; }
    } else { const float* xp = row < MLAT ? src_lat + (size_t)row * DM : src_ctx + (size_t)(row - MLAT) * DM;
#pragma unroll
      for (int i = 0; i < 2; ++i) { v[2 * i] = *(const f32x4*)(xp + i * 512 + lane * 8); v[2 * i + 1] = *(const f32x4*)(xp + i * 512 + lane * 8 + 4); } }
#pragma unroll
    for (int i = 0; i < 4; ++i) ss += v[i][0] * v[i][0] + v[i][1] * v[i][1] + v[i][2] * v[i][2] + v[i][3] * v[i][3];
    ss = wave_sum(ss);
    const float rstd = rsqrtf(ss * (1.0f / DM) + NORM_EPS);
    if (FINAL) {
#pragma unroll
      for (int i = 0; i < 2; ++i) { *(f32x4*)(outf + (size_t)row * DM + i * 512 + lane * 8) = v[2 * i] * rstd * wv4[2 * i]; *(f32x4*)(outf + (size_t)row * DM + i * 512 + lane * 8 + 4) = v[2 * i + 1] * rstd * wv4[2 * i + 1]; }
    } else {
      const int mr = row < MLAT ? row / SEQ : 4;
      const float* mp = mod + (size_t)mr * 6144;
#pragma unroll
      for (int i = 0; i < 2; ++i) { const int c = i * 512 + lane * 8;
        const f32x4 sh0 = *(const f32x4*)(mp + sh_off + c), sh1 = *(const f32x4*)(mp + sh_off + c + 4), sc0 = *(const f32x4*)(mp + sc_off + c), sc1 = *(const f32x4*)(mp + sc_off + c + 4);
        const f32x4 h0 = v[2 * i] * rstd * wv4[2 * i] * (1.0f + sc0) + sh0, h1 = v[2 * i + 1] * rstd * wv4[2 * i + 1] * (1.0f + sc1) + sh1;
        u32x4 o; o.x = pk_bf16(h0[0], h0[1]); o.y = pk_bf16(h0[2], h0[3]); o.z = pk_bf16(h1[0], h1[1]); o.w = pk_bf16(h1[2], h1[3]);
        *(u32x4*)(H + (size_t)row * DM + c) = o; }
    }
  }
}

typedef const __attribute__((address_space(4))) Params* ParamsK;
__device__ __forceinline__ ParamsK kparams() { auto kp = __builtin_amdgcn_kernarg_segment_ptr(); asm volatile("" : "+s"(kp)); return (ParamsK)kp; }
#define WSP(T, OFF) ((T*)(q->ws + (OFF)))

__device__ __forceinline__ void phase_adaln(int wsg, unsigned char* shm) {
  ParamsK q = kparams();
  const int tid = opaque_tid(wsg), lane = tid & 63, wid = tid >> 6;
  const int G = gridDim.x, bid = blockIdx.x;
  float* lds_f = (float*)shm;
  float* mod = WSP(float, WS_MOD);
  for (int it = bid; it < 2 * 96; it += G) {
    const int layer = it / 96, n0 = (it % 96) * 64;
    float* sv = lds_f;
    float* part = lds_f + 5 * 1024;
    const float* cp = q->c; const float* ccp = q->c_ctx;
    for (int e = tid; e < 5 * 1024; e += 512) { const int r = e >> 10, k = e & 1023; const float cv = r < 4 ? cp[r * DM + k] : ccp[k]; sv[e] = silu_f(cv); }
    __syncthreads();
    float a0 = 0.f, a1 = 0.f, a2 = 0.f, a3 = 0.f, a4 = 0.f;
    const float* wp = q->ada_w + (size_t)layer * DM * 6144 + n0 + lane;
    for (int k = wid * 128; k < wid * 128 + 128; ++k) { const float wv = wp[(size_t)k * 6144];
      a0 += sv[k] * wv; a1 += sv[1024 + k] * wv; a2 += sv[2048 + k] * wv; a3 += sv[3072 + k] * wv; a4 += sv[4096 + k] * wv; }
    part[(wid * 5 + 0) * 64 + lane] = a0; part[(wid * 5 + 1) * 64 + lane] = a1; part[(wid * 5 + 2) * 64 + lane] = a2; part[(wid * 5 + 3) * 64 + lane] = a3; part[(wid * 5 + 4) * 64 + lane] = a4;
    __syncthreads();
    if (tid < 320) { const int r = tid >> 6, l = tid & 63; float s = 0.f;
#pragma unroll
      for (int w8 = 0; w8 < 8; ++w8) s += part[(w8 * 5 + r) * 64 + l];
      mod[((size_t)layer * 5 + r) * 6144 + n0 + l] = s + q->ada_b[layer * 6144 + n0 + l]; }
    __syncthreads();
  }
}
__device__ __forceinline__ void phase_prologue(int wsg, unsigned char* shm) {
  ParamsK q = kparams();
  const int tid = opaque_tid(wsg);
  const int G = gridDim.x, bid = blockIdx.x;
  float* lds_f = (float*)shm;
  {
    constexpr int T_QKVA = 8 * 16, T_GU = 88 * 16, T_D = 16 * 44, T_IN = 48 * 16, T_OUT = 16 * 16;
    constexpr int T_TOTAL = T_QKVA + 2 * T_GU + 2 * T_D + T_IN + T_OUT;
    const int t = tid, chunk = (t & 15) >> 2, cc = (t & 3) * 4;
    struct TItem { const float* sp; int ld; bf16_t* dst; int Kdst; int n0, k0; };
    auto decode = [&](int it) -> TItem { TItem r; int i = it;
      if (i < T_QKVA) { const int tn = i / 16, tk = i % 16, n16 = tn * 64 + 16 * chunk; r.n0 = tn * 64; r.k0 = tk * 64; r.dst = WSP(bf16_t, WS_WQKVA); r.Kdst = DM;
        if (tn < 4) { r.sp = q->w_dq + n16; r.ld = 256; } else { r.sp = n16 < 448 ? q->w_dkv + (n16 - 256) : (const float*)nullptr; r.ld = 192; } return r; }
      i -= T_QKVA;
      for (int layer = 0; layer < 2; ++layer) {
        if (i < T_GU) { const int tn = i / 16, tk = i % 16, n16 = tn * 64 + 16 * chunk; r.n0 = tn * 64; r.k0 = tk * 64; r.dst = WSP(bf16_t, layer ? WS_WGU1 : WS_WGU0); r.Kdst = DM; r.ld = DFF;
          r.sp = ((n16 & 128) ? q->w_up : q->w_gate) + (size_t)layer * DM * DFF + (n16 >> 8) * 128 + (n16 & 127); return r; }
        i -= T_GU;
        if (i < T_D) { const int tn = i / 44, tk = i % 44, n16 = tn * 64 + 16 * chunk; r.n0 = tn * 64; r.k0 = tk * 64; r.dst = WSP(bf16_t, layer ? WS_WD1 : WS_WD0); r.Kdst = DFF; r.ld = DM;
          r.sp = q->w_down + (size_t)layer * DFF * DM + n16; return r; }
        i -= T_D;
      }
      if (i < T_IN) { const int tn = i / 16, tk = i % 16, n16 = tn * 64 + 16 * chunk; r.n0 = tn * 64; r.k0 = tk * 64; r.dst = WSP(bf16_t, WS_WIN); r.Kdst = DM; r.ld = 3 * DM;
        if (n16 < 2048) r.sp = q->conv_w_in + ((n16 & 128) ? 2048 : 1024) + (n16 >> 8) * 128 + (n16 & 127); else r.sp = q->conv_w_in + (n16 - 2048); return r; }
      i -= T_IN;
      { const int tn = i / 16, tk = i % 16, n16 = tn * 64 + 16 * chunk; r.n0 = tn * 64; r.k0 = tk * 64; r.dst = WSP(bf16_t, WS_WOUT); r.Kdst = DM; r.ld = DM; r.sp = q->conv_w_out + n16; return r; }
    };
    auto load2 = [&](const TItem& I, f32x4& v0, f32x4& v1) { v0 = (f32x4){0.f, 0.f, 0.f, 0.f}; v1 = v0;
      if (I.sp) { v0 = *(const f32x4*)(I.sp + (size_t)(I.k0 + (t >> 4)) * I.ld + cc); v1 = *(const f32x4*)(I.sp + (size_t)(I.k0 + (t >> 4) + 32) * I.ld + cc); } };
    int it = bid;
    if (it < T_TOTAL) {
      TItem cur = decode(it); f32x4 v0, v1; load2(cur, v0, v1);
      for (;;) {
        const int nit = it + G; const bool has = nit < T_TOTAL; TItem nxt = cur; f32x4 n0v = v0, n1v = v1;
        if (has) { nxt = decode(nit); load2(nxt, n0v, n1v); }
        { float* lp = lds_f + (t >> 4) * 65 + chunk * 16 + cc; lp[0] = v0[0]; lp[1] = v0[1]; lp[2] = v0[2]; lp[3] = v0[3];
          lp += 32 * 65; lp[0] = v1[0]; lp[1] = v1[1]; lp[2] = v1[2]; lp[3] = v1[3]; }
        __syncthreads();
        { const int n = t >> 3, kk = (t & 7) * 8; float a[8];
#pragma unroll
          for (int j = 0; j < 8; ++j) a[j] = lds_f[(kk + j) * 65 + n];
          u32x4 w; w.x = pk_bf16(a[0], a[1]); w.y = pk_bf16(a[2], a[3]); w.z = pk_bf16(a[4], a[5]); w.w = pk_bf16(a[6], a[7]);
          *(u32x4*)(cur.dst + (size_t)(cur.n0 + n) * cur.Kdst + cur.k0 + kk) = w; }
        __syncthreads();
        if (!has) break;
        cur = nxt; v0 = n0v; v1 = n1v; it = nit;
      }
    }
  }
  const int gt = bid * 512 + tid, nthr = G * 512;
  { const float* w_ukv = q->w_ukv; const float* w_uq = q->w_uq; bf16_t* Wuq = WSP(bf16_t, WS_WUQ);
  for (int idx = gt; idx < 1536 * 32; idx += nthr) {
    const int n = idx >> 5, jg = (idx & 31) * 8, h = n / 192, c = n % 192; float a[8];
#pragma unroll
    for (int i = 0; i < 8; ++i) a[i] = 0.f;
    if (c < 128) { const float* kr = w_ukv + (size_t)c * 2048 + h * 256;
      for (int d = 0; d < 128; d += 4) { const f32x4 kv = *(const f32x4*)(kr + d);
#pragma unroll
        for (int i = 0; i < 8; ++i) { const f32x4 qv = *(const f32x4*)(w_uq + (size_t)(jg + i) * 1536 + h * 192 + d); a[i] += qv[0] * kv[0] + qv[1] * kv[1] + qv[2] * kv[2] + qv[3] * kv[3]; } }
    } else {
#pragma unroll
      for (int i = 0; i < 8; ++i) a[i] = w_uq[(size_t)(jg + i) * 1536 + n];
    }
    u32x4 w; w.x = pk_bf16(a[0], a[1]); w.y = pk_bf16(a[2], a[3]); w.z = pk_bf16(a[4], a[5]); w.w = pk_bf16(a[6], a[7]);
    *(u32x4*)(Wuq + (size_t)n * 256 + jg) = w;
  } }
  { const float* w_ukv = q->w_ukv; const float* w_o = q->w_o; bf16_t* Wo = WSP(bf16_t, WS_WO);
  for (int idx = gt; idx < 1024 * 128; idx += nthr) {
    const int n = idx & 1023, kg = __builtin_amdgcn_readfirstlane(idx >> 10), h = kg >> 4, c0 = (kg & 15) * 8; float a[8];
#pragma unroll
    for (int i = 0; i < 8; ++i) a[i] = 0.f;
    const float* wop = w_o + (size_t)(h * 128) * DM + n; const float* vr = w_ukv + (size_t)c0 * 2048 + h * 256 + 128;
    for (int d = 0; d < 128; ++d) { const float wv = wop[(size_t)d * DM];
#pragma unroll
      for (int i = 0; i < 8; ++i) a[i] += vr[(size_t)i * 2048 + d] * wv; }
    u32x4 w; w.x = pk_bf16(a[0], a[1]); w.y = pk_bf16(a[2], a[3]); w.z = pk_bf16(a[4], a[5]); w.w = pk_bf16(a[6], a[7]);
    *(u32x4*)(Wo + (size_t)n * DM + h * 128 + c0) = w;
  } }
}

__device__ __forceinline__ void phase_qkv_post(int wsg) {
  ParamsK q = kparams();
  const int tid = opaque_tid(wsg), lane = tid & 63, wid = tid >> 6;
  const int wv = blockIdx.x * 8 + wid, nw = gridDim.x * 8;
  const bf16_t* QKVA = WSP(bf16_t, WS_QKVA); bf16_t* QAN = WSP(bf16_t, WS_QAN); bf16_t* KV = WSP(bf16_t, WS_KV);
  const f32x4 qn = *(const f32x4*)(q->q_norm + lane * 4);
  const float kn0 = q->kv_norm[lane * 2], kn1 = q->kv_norm[lane * 2 + 1];
  const float frev = rope_freq_rev(lane & 15);
  for (int row = wv; row < MALL; row += nw) {
    const bf16_t* rp = QKVA + (size_t)row * 512;
    const u32x2 qa = *(const u32x2*)(rp + lane * 4); const unsigned ka = *(const unsigned*)(rp + 256 + lane * 2); const float kr = bf_lo((unsigned)rp[384 + lane]);
    const float q0 = bf_lo(qa.x), q1 = bf_hi(qa.x), q2 = bf_lo(qa.y), q3 = bf_hi(qa.y), k0 = bf_lo(ka), k1 = bf_hi(ka);
    const float qss = wave_sum(q0 * q0 + q1 * q1 + q2 * q2 + q3 * q3), kss = wave_sum(k0 * k0 + k1 * k1);
    const float qr = rsqrtf(qss * (1.0f / 256.0f) + NORM_EPS), krs = rsqrtf(kss * (1.0f / 128.0f) + NORM_EPS);
    size_t kvrow; float kro = kr;
    if (row < MLAT) { const int b = row / SEQ, t = row % SEQ; kvrow = (size_t)b * SKV + CTX + t;
      u32x2 o; o.x = pk_bf16(q0 * qr * qn[0], q1 * qr * qn[1]); o.y = pk_bf16(q2 * qr * qn[2], q3 * qr * qn[3]);
      *(u32x2*)(QAN + (size_t)row * 256 + lane * 4) = o;
      const float pos = (float)(lane < 32 ? (t >> 6) : (t & 63)); float s, c; sincos_rev(pos * frev, s, c);
      const float xp = __shfl_xor(kr, 16);
      kro = (lane & 16) ? kr * c + xp * s : kr * c - xp * s;
    } else { const int r2 = row - MLAT; kvrow = (size_t)(r2 / CTX) * SKV + (r2 % CTX); }
    bf16_t* kp = KV + kvrow * DQK;
    *(unsigned*)(kp + lane * 2) = pk_bf16(k0 * krs * kn0, k1 * krs * kn1);
    kp[128 + lane] = (bf16_t)(pk_bf16(kro, 0.f) & 0xffffu);
  }
}

__device__ __forceinline__ void phase_attn(int wsg, unsigned char* shm) {
  ParamsK q = kparams();
  const bf16_t* Qb = WSP(bf16_t, WS_Q); const bf16_t* KV = WSP(bf16_t, WS_KV); bf16_t* Ob = WSP(bf16_t, WS_O);
  for (int u = blockIdx.x; u < NB * NH * (SEQ / 256); u += gridDim.x) {
    const int w = u & 255, r = u >> 8, xcd = w & 7, slot = w >> 3;
    const int b = xcd >> 1, idx = (xcd & 1) * 128 + r * 32 + slot, h = idx >> 5, qb = idx & 31;
    __syncthreads();
    att::attn_unit(wsg, Qb + ((size_t)(b * SEQ + qb * 256) * 1536 + h * DQK), KV + (size_t)b * SKV * DQK, Ob + ((size_t)(b * SEQ + qb * 256) * DM + h * 128), (LAS unsigned char*)shm);
  }
}

__device__ __forceinline__ void phase_conv(int wsg) {
  ParamsK q = kparams();
  const int tid = opaque_tid(wsg);
  const bf16_t* CV = WSP(bf16_t, WS_CV); const bf16_t* BG = WSP(bf16_t, WS_BG); bf16_t* Z = WSP(bf16_t, WS_Z);
  const float* cw = q->conv_w;
  const size_t nitem = (size_t)MLAT * DM / 8;
  for (size_t it = (size_t)blockIdx.x * 512 + tid; it < nitem; it += (size_t)gridDim.x * 512) {
    const int row = (int)(it >> 7), d0 = (int)(it & 127) * 8, t = row & (SEQ - 1);
    const u32x4 cur = *(const u32x4*)(CV + (size_t)row * DM + d0);
    u32x4 prv = (u32x4){0u, 0u, 0u, 0u}, nxt = (u32x4){0u, 0u, 0u, 0u};
    if (t > 0) prv = *(const u32x4*)(CV + (size_t)(row - 1) * DM + d0);
    if (t < SEQ - 1) nxt = *(const u32x4*)(CV + (size_t)(row + 1) * DM + d0);
    const u32x4 bg = *(const u32x4*)(BG + (size_t)row * DM + d0);
    const float* w0 = cw + d0; const float* w1 = cw + DM + d0; const float* w2 = cw + 2 * DM + d0;
    u32x4 o;
#pragma unroll
    for (int k = 0; k < 4; ++k) {
      const float ul = w0[2 * k] * bf_lo(prv[k]) + w1[2 * k] * bf_lo(cur[k]) + w2[2 * k] * bf_lo(nxt[k]);
      const float uh = w0[2 * k + 1] * bf_hi(prv[k]) + w1[2 * k + 1] * bf_hi(cur[k]) + w2[2 * k + 1] * bf_hi(nxt[k]);
      o[k] = pk_bf16(bf_lo(bg[k]) * ul, bf_hi(bg[k]) * uh); }
    *(u32x4*)(Z + (size_t)row * DM + d0) = o;
  }
}

#define GEMM_SETUP(M_, N_) ParamsK q = kparams(); pg8::StaticOrder S; S.init((M_), (N_), gridDim.x, blockIdx.x); LAS unsigned char* ldsl = (LAS unsigned char*)shm
__device__ __forceinline__ void phase_gemm_qkva(int wsg, unsigned char* shm) { GEMM_SETUP(MALL, 512);
  pg8::Gemm g{WSP(bf16_t, WS_H), WSP(bf16_t, WS_WQKVA), MALL, 512, DM}; pg8::EpiBf16 E{WSP(bf16_t, WS_QKVA), 512}; pg8::gemm_phase(wsg, ldsl, g, S, E); }
__device__ __forceinline__ void phase_gemm_uq(int wsg, unsigned char* shm) { GEMM_SETUP(MLAT, 1536);
  pg8::Gemm g{WSP(bf16_t, WS_QAN), WSP(bf16_t, WS_WUQ), MLAT, 1536, 256}; pg8::EpiQRope E{WSP(bf16_t, WS_Q)}; pg8::gemm_phase(wsg, ldsl, g, S, E); }
__device__ __forceinline__ void phase_gemm_mixout0(int wsg, unsigned char* shm) { GEMM_SETUP(MLAT, DM);
  pg8::Gemm g{WSP(bf16_t, WS_O), WSP(bf16_t, WS_WO), MLAT, DM, DM};
  pg8::EpiResid<true> E{q->x, WSP(bf16_t, WS_X16), WSP(float, WS_MOD) + 2048}; pg8::gemm_phase(wsg, ldsl, g, S, E); }
__device__ __forceinline__ void phase_gemm_mixout1(int wsg, unsigned char* shm) { GEMM_SETUP(MLAT, DM);
  pg8::Gemm g{WSP(bf16_t, WS_Z), WSP(bf16_t, WS_WOUT), MLAT, DM, DM};
  pg8::EpiResid<false> E{WSP(bf16_t, WS_X16), WSP(bf16_t, WS_X16), WSP(float, WS_MOD) + (size_t)5 * 6144 + 2048}; pg8::gemm_phase(wsg, ldsl, g, S, E); }
__device__ __forceinline__ void phase_gemm_convin(int wsg, unsigned char* shm) { GEMM_SETUP(MLAT, 3 * DM);
  pg8::Gemm g{WSP(bf16_t, WS_H), WSP(bf16_t, WS_WIN), MLAT, 3 * DM, DM}; pg8::EpiConvIn E{WSP(bf16_t, WS_CV), WSP(bf16_t, WS_BG)}; pg8::gemm_phase(wsg, ldsl, g, S, E); }
__device__ __forceinline__ void phase_gemm_gu(int wsg, unsigned char* shm, int layer) { GEMM_SETUP(MLAT, 2 * DFF);
  pg8::Gemm g{WSP(bf16_t, WS_H), WSP(bf16_t, layer ? WS_WGU1 : WS_WGU0), MLAT, 2 * DFF, DM}; pg8::EpiSwiglu E{WSP(bf16_t, WS_G), DFF}; pg8::gemm_phase(wsg, ldsl, g, S, E); }
__device__ __forceinline__ void phase_gemm_down(int wsg, unsigned char* shm, int layer) { GEMM_SETUP(MLAT, DM);
  pg8::Gemm g{WSP(bf16_t, WS_G), WSP(bf16_t, layer ? WS_WD1 : WS_WD0), MLAT, DM, DFF};
  pg8::EpiResid<false> E{WSP(bf16_t, WS_X16), WSP(bf16_t, WS_X16), WSP(float, WS_MOD) + (size_t)layer * 5 * 6144 + 5120}; pg8::gemm_phase(wsg, ldsl, g, S, E); }

#define XB_TMO      128
#define XB_XCNT(j)  (256  + 64 * (j))
#define XB_XSUB(j)  (1280 + 64 * (j))
#define XB_XGEN(j)  (2304 + 64 * (j))
#define XB_TOP      3328
#define XB_TOPGEN   3392
#define XB_SPIN_CAP (1u << 20)
constexpr int LDS_XB = LDS_BYTES - 16;
__device__ __forceinline__ unsigned xb_ld(unsigned* p)              { return __hip_atomic_load(p, __ATOMIC_RELAXED, __HIP_MEMORY_SCOPE_AGENT); }
__device__ __forceinline__ unsigned xb_add(unsigned* p, unsigned v) { return __hip_atomic_fetch_add(p, v, __ATOMIC_RELAXED, __HIP_MEMORY_SCOPE_AGENT); }
__device__ __forceinline__ unsigned xb_xcc_id() { return (unsigned)__builtin_amdgcn_s_getreg((3 << 11) | 20) & 0xFu; }
#define XB_SPIN(cond, bar) do { unsigned _sp = 0; while (cond) { __builtin_amdgcn_s_sleep(1); \
    if ((++_sp & 255u) == 0u) { if (xb_ld(&(bar)[XB_TMO])) break; if (_sp > XB_SPIN_CAP) { atomicAdd(&(bar)[XB_TMO], 1u); break; } } } } while (0)
__device__ __forceinline__ void xcd_barrier_complete(unsigned* bar, unsigned x, unsigned& nloc, unsigned& nx) {
  const unsigned G = gridDim.x;
  unsigned sum, cnt, mine, sp = 0u;
  for (;;) {
    sum = 0u; cnt = 0u; mine = 0u;
#pragma unroll
    for (unsigned j = 0; j < 16; ++j) { const unsigned c = xb_ld(&bar[XB_XCNT(j)]); sum += c; cnt += (c > 0u) ? 1u : 0u; mine = (j == x) ? c : mine; }
    if (sum == G) break;
    __builtin_amdgcn_s_sleep(1);
    if ((++sp & 255u) == 0u) { if (xb_ld(&bar[XB_TMO])) break; if (sp > XB_SPIN_CAP) { atomicAdd(&bar[XB_TMO], 1u); break; } }
  }
  nloc = mine > 0u ? mine : 1u; nx = cnt > 0u ? cnt : 1u;
}
__device__ __forceinline__ void grid_bar_post(int wsg, unsigned char* shm) {
  ParamsK q = kparams(); unsigned* bar = (unsigned*)q->ws; const unsigned x = xb_xcc_id();
  if (opaque_tid(wsg) == 0) { volatile LAS unsigned* st = (volatile LAS unsigned*)((LAS unsigned char*)shm + LDS_XB); st[0] = 0u; st[1] = 0u;
    (void)xb_add(&bar[XB_XCNT(x)], 1u); }
  __syncthreads();
}
__device__ __forceinline__ void grid_bar(int wsg, unsigned char* shm) {
  asm volatile("s_waitcnt vmcnt(0)" ::: "memory");
  __syncthreads();
  ParamsK q = kparams(); unsigned* bar = (unsigned*)q->ws; const unsigned x = xb_xcc_id();
  if (opaque_tid(wsg) == 0) {
    volatile LAS unsigned* st = (volatile LAS unsigned*)((LAS unsigned char*)shm + LDS_XB);
    __builtin_amdgcn_s_waitcnt(0);
    unsigned nloc = st[0], nx = st[1];
    if (nloc == 0u) { xcd_barrier_complete(bar, x, nloc, nx); st[0] = nloc; st[1] = nx; }
    const unsigned old = xb_add(&bar[XB_XSUB(x)], 1u);
    const unsigned gen = old / nloc;
    if (old + 1u == (gen + 1u) * nloc) {
      __builtin_amdgcn_fence(__ATOMIC_RELEASE, "agent");
      asm volatile("s_waitcnt vmcnt(0)" ::: "memory");
      const unsigned og = xb_add(&bar[XB_TOP], 1u);
      const unsigned tg = og / nx;
      if (og + 1u == (tg + 1u) * nx) xb_add(&bar[XB_TOPGEN], 1u);
      else XB_SPIN(xb_ld(&bar[XB_TOPGEN]) == tg, bar);
      __builtin_amdgcn_fence(__ATOMIC_ACQUIRE, "agent");
      xb_add(&bar[XB_XGEN(x)], 1u);
      asm volatile("s_waitcnt vmcnt(0)" ::: "memory");
    } else {
      XB_SPIN(xb_ld(&bar[XB_XGEN(x)]) == gen, bar);
      __builtin_amdgcn_fence(__ATOMIC_ACQUIRE, "agent");
      asm volatile("s_waitcnt vmcnt(0)" ::: "memory");
    }
  }
  __syncthreads();
}


__device__ __forceinline__ void phase_norm_mix0(int wsg) { ParamsK q = kparams();
  norm_rows<false, false>(wsg, q->x, q->ctx, nullptr, MALL, q->norm_mix, WSP(float, WS_MOD), 0, 1024, WSP(bf16_t, WS_H), nullptr); }
__device__ __forceinline__ void phase_norm_mix1(int wsg) { ParamsK q = kparams();
  norm_rows<false, true>(wsg, nullptr, nullptr, WSP(bf16_t, WS_X16), MLAT, q->norm_mix + DM, WSP(float, WS_MOD) + (size_t)5 * 6144, 0, 1024, WSP(bf16_t, WS_H), nullptr); }
template <int LAYER> __device__ __forceinline__ void phase_norm_ffn(int wsg) { ParamsK q = kparams();
  norm_rows<false, true>(wsg, nullptr, nullptr, WSP(bf16_t, WS_X16), MLAT, q->norm_ffn + LAYER * DM, WSP(float, WS_MOD) + (size_t)LAYER * 5 * 6144, 3072, 4096, WSP(bf16_t, WS_H), nullptr); }

__global__ void __launch_bounds__(512, 2) mk_fwd(Params p) {
  extern __shared__ __attribute__((aligned(16))) unsigned char shm[];
  cg::grid_group grid = cg::this_grid();
  const int wsg = __builtin_amdgcn_readfirstlane((int)(threadIdx.x >> 6));
  grid_bar_post(wsg, shm);
  phase_adaln(wsg, shm);
  grid.sync();
  phase_norm_mix0(wsg); phase_prologue(wsg, shm); grid_bar(wsg, shm);
  phase_gemm_qkva(wsg, shm); grid_bar(wsg, shm);
  phase_qkv_post(wsg); grid_bar(wsg, shm);
  phase_gemm_uq(wsg, shm); grid_bar(wsg, shm);
  phase_attn(wsg, shm); grid_bar(wsg, shm);
  phase_gemm_mixout0(wsg, shm); grid_bar(wsg, shm);
  phase_norm_ffn<0>(wsg); grid_bar(wsg, shm);
  phase_gemm_gu(wsg, shm, 0); grid_bar(wsg, shm);
  phase_gemm_down(wsg, shm, 0); grid_bar(wsg, shm);
  phase_norm_mix1(wsg); grid_bar(wsg, shm);
  phase_gemm_convin(wsg, shm); grid_bar(wsg, shm);
  phase_conv(wsg); grid_bar(wsg, shm);
  phase_gemm_mixout1(wsg, shm); grid_bar(wsg, shm);
  phase_norm_ffn<1>(wsg); grid_bar(wsg, shm);
  phase_gemm_gu(wsg, shm, 1); grid_bar(wsg, shm);
  phase_gemm_down(wsg, shm, 1); grid_bar(wsg, shm);
  { ParamsK q = kparams(); norm_rows<true, true>(wsg, nullptr, nullptr, WSP(bf16_t, WS_X16), MLAT, q->final_norm, nullptr, 0, 0, nullptr, q->out); }
}

extern "C" void kernel_launch(void* const* d_in, const int* in_sizes, int n_in, void* d_out, int out_size, void* d_ws, size_t ws_size, hipStream_t stream) {
  static int grid_blocks = 0;
  if (!grid_blocks) {
    if (ws_size < WS_END) { fprintf(stderr, "kernel_launch: ws too small %zu < %zu\n", ws_size, (size_t)WS_END); return; }
    if (hipFuncSetAttribute((const void*)mk_fwd, hipFuncAttributeMaxDynamicSharedMemorySize, LDS_BYTES) != hipSuccess) { fprintf(stderr, "kernel_launch: set LDS attr failed\n"); return; }
    int dev = 0, cus = 0, per_cu = 0;
    (void)hipGetDevice(&dev);
    (void)hipDeviceGetAttribute(&cus, hipDeviceAttributeMultiprocessorCount, dev);
    (void)hipOccupancyMaxActiveBlocksPerMultiprocessor(&per_cu, mk_fwd, 512, LDS_BYTES);
    if (per_cu < 1) { fprintf(stderr, "kernel_launch: occupancy 0\n"); return; }
    grid_blocks = cus;
  }
  Params p{};
  p.x = (const float*)d_in[0]; p.c = (const float*)d_in[1]; p.ctx = (const float*)d_in[2]; p.c_ctx = (const float*)d_in[3];
  p.ada_w = (const float*)d_in[4]; p.ada_b = (const float*)d_in[5]; p.norm_mix = (const float*)d_in[6]; p.norm_ffn = (const float*)d_in[7];
  p.w_dq = (const float*)d_in[8]; p.q_norm = (const float*)d_in[9]; p.w_uq = (const float*)d_in[10]; p.w_dkv = (const float*)d_in[11];
  p.kv_norm = (const float*)d_in[12]; p.w_ukv = (const float*)d_in[13]; p.w_o = (const float*)d_in[14];
  p.conv_w_in = (const float*)d_in[15]; p.conv_w = (const float*)d_in[16]; p.conv_w_out = (const float*)d_in[17];
  p.w_gate = (const float*)d_in[18]; p.w_up = (const float*)d_in[19]; p.w_down = (const float*)d_in[20]; p.final_norm = (const float*)d_in[21];
  p.out = (float*)d_out; p.ws = (unsigned char*)d_ws;
  void* args[] = {&p};
  (void)hipMemsetAsync(d_ws, 0, 16384, stream);
  hipError_t e = hipLaunchCooperativeKernel((void*)mk_fwd, dim3(grid_blocks), dim3(512), args, LDS_BYTES, stream);
  if (e != hipSuccess) fprintf(stderr, "cooperative launch failed: %s (grid %d)\n", hipGetErrorString(e), grid_blocks);
}
```

```cpp
#include <hip/hip_runtime.h>
#include <hip/hip_cooperative_groups.h>
#include <cstdio>
#include <cstdint>
namespace cg = cooperative_groups;

typedef unsigned short bf16_t;
typedef short bf16x8 __attribute__((ext_vector_type(8)));
typedef short s16x4 __attribute__((ext_vector_type(4)));
typedef float f32x4 __attribute__((ext_vector_type(4)));
typedef float f32x16 __attribute__((ext_vector_type(16)));
typedef unsigned u32x4 __attribute__((ext_vector_type(4)));
typedef unsigned u32x2 __attribute__((ext_vector_type(2)));
#define LAS __attribute__((address_space(3)))

constexpr int DM = 1024, NB = 4, SEQ = 8192, CTX = 256, NH = 8, DFF = 2816;
constexpr int MLAT = NB * SEQ;
constexpr int MCTX = NB * CTX;
constexpr int MALL = MLAT + MCTX;
constexpr int SKV = CTX + SEQ;
constexpr int DQK = 192;
constexpr float NORM_EPS = 1e-6f;

constexpr size_t MiB = 1u << 20;
constexpr size_t WS_MOD = 1 * MiB;
constexpr size_t WS_WQKVA = 2 * MiB;
constexpr size_t WS_WUQ = 3 * MiB;
constexpr size_t WS_WO = 4 * MiB;
constexpr size_t WS_WGU0 = 6 * MiB;
constexpr size_t WS_WD0 = 17 * MiB;
constexpr size_t WS_WIN = 23 * MiB;
constexpr size_t WS_WOUT = 29 * MiB;
constexpr size_t WS_WGU1 = 31 * MiB;
constexpr size_t WS_WD1 = 42 * MiB;
constexpr size_t WS_H = 48 * MiB;
constexpr size_t WS_BIG = 116 * MiB;
constexpr size_t WS_QKVA = WS_BIG;
constexpr size_t WS_QAN = WS_BIG + 33 * MiB;
constexpr size_t WS_KV = WS_BIG + 49 * MiB;
constexpr size_t WS_Q = WS_BIG + 64 * MiB;
constexpr size_t WS_O = WS_BIG + 160 * MiB;
constexpr size_t WS_G = WS_BIG;
constexpr size_t WS_CV = WS_BIG;
constexpr size_t WS_BG = WS_BIG + 64 * MiB;
constexpr size_t WS_Z = WS_BIG + 128 * MiB;
constexpr size_t WS_X16 = WS_BIG + 224 * MiB;
constexpr size_t WS_END = WS_BIG + 288 * MiB;
static_assert(WS_KV + (size_t)NB * SKV * DQK * 2 <= WS_Q && WS_QAN + (size_t)MLAT * 256 * 2 <= WS_KV && WS_QKVA + (size_t)MALL * 512 * 2 <= WS_QAN && WS_Q + (size_t)MLAT * 1536 * 2 <= WS_O && WS_O + (size_t)MLAT * DM * 2 <= WS_END && WS_G + (size_t)MLAT * DFF * 2 <= WS_END && WS_H + (size_t)MALL * DM * 2 <= WS_BIG, "ws map");

constexpr int LDS_BYTES = 163840;

typedef float f32x2_t __attribute__((ext_vector_type(2)));
typedef __bf16 bf16x2_t __attribute__((ext_vector_type(2)));
__device__ __forceinline__ unsigned pk_bf16(float lo, float hi) { const f32x2_t v = {lo, hi}; const bf16x2_t b = __builtin_convertvector(v, bf16x2_t); return __builtin_bit_cast(unsigned, b); }
__device__ __forceinline__ float bf_lo(unsigned u) { return __uint_as_float(u << 16); }
__device__ __forceinline__ float bf_hi(unsigned u) { return __uint_as_float(u & 0xffff0000u); }
__device__ __forceinline__ float wave_sum(float v) {
#pragma unroll
  for (int o = 32; o >= 1; o >>= 1) v += __shfl_xor(v, o);
  return v;
}
__device__ __forceinline__ int opaque_tid(int wsg) { int t; asm volatile("v_mbcnt_lo_u32_b32 %0, -1, 0\n\tv_mbcnt_hi_u32_b32 %0, -1, %0\n\tv_lshl_or_b32 %0, %1, 6, %0" : "=&v"(t) : "s"(wsg)); return t; }
__device__ __forceinline__ float silu_f(float x) { return x / (1.0f + __expf(-x)); }
__device__ __forceinline__ float rope_freq_rev(int i) { return __builtin_amdgcn_exp2f(-(float)i * (13.287712379549449f / 16.0f)) * 0.15915494309189535f; }
__device__ __forceinline__ void sincos_rev(float rev, float& s, float& c) { float f = rev - floorf(rev); s = __builtin_amdgcn_sinf(f); c = __builtin_amdgcn_cosf(f); }

namespace pg8 {
constexpr int BM = 256, BK = 64, HALF = 128, HTB = HALF * BK * 2, STAGE_BYTES = 8 * HTB, NXCD = 8, WGM = 8;
__device__ __forceinline__ int lds_byte(int r, int c) { const int st = (r >> 4) * 2 + (c >> 5), rr = r & 15, cc = c & 31, ob = rr * 64 + cc * 2; return st * 1024 + (ob ^ (((ob >> 9) & 1) << 5)); }
__device__ __forceinline__ void stage_rc(int b, int& R, int& C) { const int st = b / 1024, sb = b % 1024, swz = sb ^ (((sb >> 9) & 1) << 5); R = (st >> 1) * 16 + swz / 64; C = (st & 1) * 32 + (swz % 64) / 2; }
__device__ __forceinline__ int perm32(int rho) { const int n = rho >> 4, i = rho & 15; return 8 * (i >> 2) + 4 * n + (i & 3); }
struct Unit { int pm, pn; };
struct Gemm { const bf16_t* A; const bf16_t* Bt; int M, N, K; };
struct StaticOrder {
  int nM, nN, nwg, G, c;
  __device__ void init(int M, int N, int G_, int c_) { nM = M / BM; nN = N / BM; nwg = nM * nN; G = G_; c = c_; }
  __device__ bool next(int i, Unit& u) const {
    const long L = (long)i * G + c; if (L >= nwg) return false;
    int wgid = (int)L; { const int q = nwg / NXCD, r = nwg % NXCD, xcd = wgid % NXCD, off = wgid / NXCD; wgid = (xcd < r ? xcd * (q + 1) : r * (q + 1) + (xcd - r) * q) + off; }
    const int nig = WGM * nN, gid = wgid / nig, fm = gid * WGM, gsz = (nM - fm) < WGM ? (nM - fm) : WGM;
    u.pm = fm + ((wgid % nig) % gsz); u.pn = (wgid % nig) / gsz; return true;
  }
};

template <class Epi>
__device__ __forceinline__ void gemm_phase(int wsg, LAS unsigned char* lds, const Gemm g, const StaticOrder& S, const Epi& E) {
  const int tid = opaque_tid(wsg), wid = __builtin_amdgcn_readfirstlane(tid >> 6), lane = tid & 63, wr = wid >> 2, wc = wid & 3, fr = lane & 15, fq = lane >> 4;
  const int K = g.K, nt = K / BK;
  unsigned voffA[2], voffB[2];
#pragma unroll
  for (int i = 0; i < 2; ++i) { int R, C; stage_rc(tid * 16 + i * 8192, R, C); const int Rb = Epi::PERM ? ((R & ~31) + perm32(R & 31)) : R;
    voffA[i] = (unsigned)(R * K + C) * 2u; voffB[i] = (unsigned)(Rb * K + C) * 2u; }
  const size_t kstep = (size_t)(BK * 2);
  const size_t hstep = (size_t)HALF * K * 2;
  const size_t tstep = 2 * hstep;
  const unsigned ldsw = (unsigned)wid * 1024u;
  const int aoff = lds_byte(wr * 64 + fr, fq * 8), boff = lds_byte(wc * 32 + fr, fq * 8);
#define PG8_SA(b, h) (((b) * 2 + (h)) * HTB)
#define PG8_SB(b, h) ((4 + (b) * 2 + (h)) * HTB)
#define PG8_STAGE(bufoff, gbase, voff) do { _Pragma("unroll") for (int _i = 0; _i < 2; ++_i) \
    __builtin_amdgcn_global_load_lds((const unsigned*)((const char*)(gbase) + (voff)[_i]), (LAS unsigned*)(lds + (bufoff) + ldsw + _i * 8192), 16, 0, 0); } while (0)
#define PG8_LDA(dst, b, h) do { _Pragma("unroll") for (int m = 0; m < 4; ++m) _Pragma("unroll") for (int k = 0; k < 2; ++k) dst[m][k] = *(const LAS bf16x8*)(lds + PG8_SA(b, h) + aoff + m * 2048 + k * 1024); } while (0)
#define PG8_LDB(dst, b, h) do { _Pragma("unroll") for (int n = 0; n < 2; ++n) _Pragma("unroll") for (int k = 0; k < 2; ++k) dst[n][k] = *(const LAS bf16x8*)(lds + PG8_SB(b, h) + boff + n * 2048 + k * 1024); } while (0)
#define PG8_MMA(ai, bj, At, Bt) do { __builtin_amdgcn_s_setprio(1); _Pragma("unroll") for (int m = 0; m < 4; ++m) _Pragma("unroll") for (int n = 0; n < 2; ++n) _Pragma("unroll") for (int k = 0; k < 2; ++k) \
    acc[ai][bj][m][n] = __builtin_amdgcn_mfma_f32_16x16x32_bf16(Bt[n][k], At[m][k], acc[ai][bj][m][n], 0, 0, 0); __builtin_amdgcn_s_setprio(0); } while (0)
#define PG8_WAIT_V(n) asm volatile("s_waitcnt vmcnt(" #n ")" ::: "memory")
#define PG8_WAIT_L(n) asm volatile("s_waitcnt lgkmcnt(" #n ")" ::: "memory")
#define PG8_BAR __builtin_amdgcn_s_barrier()
#define PG8_SCHED __builtin_amdgcn_sched_barrier(0)
  Unit cur, nxt; int ui = 0;
  if (!S.next(0, cur)) return;
  f32x4 acc[2][2][4][2];
#pragma unroll
  for (int a = 0; a < 2; ++a)
#pragma unroll
    for (int b = 0; b < 2; ++b)
#pragma unroll
      for (int m = 0; m < 4; ++m)
#pragma unroll
        for (int n = 0; n < 2; ++n) acc[a][b][m][n] = (f32x4){0.f, 0.f, 0.f, 0.f};
  bf16x8 At[4][2], B0[2][2], B1[2][2];
  const char* cA = (const char*)g.A + (size_t)cur.pm * tstep; const char* cB = (const char*)g.Bt + (size_t)cur.pn * tstep;
  PG8_STAGE(PG8_SB(0, 0), cB, voffB); PG8_STAGE(PG8_SA(0, 0), cA, voffA); PG8_STAGE(PG8_SB(0, 1), cB + hstep, voffB); PG8_STAGE(PG8_SA(0, 1), cA + hstep, voffA);
  if (wr == 1) PG8_BAR;
  PG8_WAIT_V(4); PG8_BAR;
  PG8_STAGE(PG8_SB(1, 0), cB + kstep, voffB); PG8_STAGE(PG8_SA(1, 0), cA + kstep, voffA); PG8_STAGE(PG8_SB(1, 1), cB + hstep + kstep, voffB);
  PG8_WAIT_V(6); PG8_BAR;
  for (;;) {
    const bool has_next = S.next(ui + 1, nxt);
    const char* nA = has_next ? (const char*)g.A + (size_t)nxt.pm * tstep : cA; const char* nB = has_next ? (const char*)g.Bt + (size_t)nxt.pn * tstep : cB;
    for (int t = 0; t < nt; t += 2) {
      const bool last = (t == nt - 2);
      const char* a1 = cA + (size_t)(t + 1) * kstep;
      const char* a2 = last ? nA : cA + (size_t)(t + 2) * kstep; const char* b2 = last ? nB : cB + (size_t)(t + 2) * kstep;
      const char* a3 = a2 + kstep; const char* b3 = b2 + kstep;
      PG8_LDB(B0, 0, 0); PG8_SCHED; PG8_LDA(At, 0, 0); PG8_STAGE(PG8_SA(1, 1), a1 + hstep, voffA);
      PG8_WAIT_L(8); PG8_BAR; PG8_WAIT_L(0); PG8_MMA(0, 0, At, B0); PG8_BAR; PG8_SCHED;
      PG8_LDB(B1, 0, 1); PG8_STAGE(PG8_SB(0, 0), b2, voffB);
      PG8_BAR; PG8_WAIT_L(0); PG8_MMA(0, 1, At, B1); PG8_BAR;
      PG8_LDA(At, 0, 1); PG8_STAGE(PG8_SA(0, 0), a2, voffA);
      PG8_BAR; PG8_WAIT_L(0); PG8_MMA(1, 0, At, B0); PG8_BAR; PG8_SCHED;
      PG8_STAGE(PG8_SB(0, 1), b2 + hstep, voffB);
      PG8_WAIT_V(6); PG8_BAR; PG8_MMA(1, 1, At, B1); PG8_BAR;
      PG8_LDB(B0, 1, 0); PG8_SCHED; PG8_LDA(At, 1, 0); PG8_STAGE(PG8_SA(0, 1), a2 + hstep, voffA);
      PG8_WAIT_L(8); PG8_BAR; PG8_WAIT_L(0); PG8_MMA(0, 0, At, B0); PG8_BAR; PG8_SCHED;
      PG8_LDB(B1, 1, 1); PG8_STAGE(PG8_SB(1, 0), b3, voffB);
      PG8_BAR; PG8_WAIT_L(0); PG8_MMA(0, 1, At, B1); PG8_BAR;
      PG8_LDA(At, 1, 1); PG8_STAGE(PG8_SA(1, 0), a3, voffA);
      PG8_BAR; PG8_WAIT_L(0); PG8_MMA(1, 0, At, B0); PG8_BAR; PG8_SCHED;
      PG8_STAGE(PG8_SB(1, 1), b3 + hstep, voffB);
      PG8_WAIT_V(6); PG8_BAR; PG8_MMA(1, 1, At, B1); PG8_BAR;
    }
    E(acc, cur, wr, wc, fr, fq);
    if (!has_next) break;
#pragma unroll
    for (int a = 0; a < 2; ++a)
#pragma unroll
      for (int b = 0; b < 2; ++b)
#pragma unroll
        for (int m = 0; m < 4; ++m)
#pragma unroll
          for (int n = 0; n < 2; ++n) acc[a][b][m][n] = (f32x4){0.f, 0.f, 0.f, 0.f};
    cur = nxt; cA = nA; cB = nB; ++ui;
  }
  PG8_WAIT_V(0);
  if (wr == 0) PG8_BAR;
  PG8_BAR;
#undef PG8_SA
#undef PG8_SB
#undef PG8_STAGE
#undef PG8_LDA
#undef PG8_LDB
#undef PG8_MMA
#undef PG8_WAIT_V
#undef PG8_WAIT_L
#undef PG8_BAR
#undef PG8_SCHED
}

struct EpiBf16 {
  static constexpr bool PERM = true;
  bf16_t* O; int ldc;
  __device__ __forceinline__ void operator()(const f32x4 (&acc)[2][2][4][2], const Unit& u, int wr, int wc, int fr, int fq) const {
    const int row0 = u.pm * BM + wr * 64 + fr, col0 = u.pn * BM + wc * 32 + 8 * fq;
#pragma unroll
    for (int ai = 0; ai < 2; ++ai)
#pragma unroll
      for (int m = 0; m < 4; ++m) { bf16_t* rowp = O + (size_t)(row0 + ai * HALF + m * 16) * ldc + col0;
#pragma unroll
        for (int bj = 0; bj < 2; ++bj) { const f32x4 v0 = acc[ai][bj][m][0], v1 = acc[ai][bj][m][1];
          u32x4 w; w.x = pk_bf16(v0[0], v0[1]); w.y = pk_bf16(v0[2], v0[3]); w.z = pk_bf16(v1[0], v1[1]); w.w = pk_bf16(v1[2], v1[3]);
          *(u32x4*)(rowp + bj * HALF) = w; } }
  }
};
struct EpiQRope {
  static constexpr bool PERM = false;
  bf16_t* O;
  __device__ __forceinline__ void operator()(const f32x4 (&acc)[2][2][4][2], const Unit& u, int wr, int wc, int fr, int fq) const {
    const int row0 = u.pm * BM + wr * 64 + fr;
    float fr_rev[4];
#pragma unroll
    for (int j = 0; j < 4; ++j) fr_rev[j] = rope_freq_rev(4 * fq + j);
#pragma unroll
    for (int bj = 0; bj < 2; ++bj) {
      const int gq = u.pn * 8 + bj * 4 + wc;
      const int within = gq % 6;
      const int col0 = gq * 32 + 4 * fq;
#pragma unroll
      for (int ai = 0; ai < 2; ++ai)
#pragma unroll
        for (int m = 0; m < 4; ++m) {
          const int row = row0 + ai * HALF + m * 16;
          f32x4 v0 = acc[ai][bj][m][0], v1 = acc[ai][bj][m][1];
          if (within >= 4) {
            const int t = row & (SEQ - 1);
            const float pos = (float)(within == 4 ? (t >> 6) : (t & 63));
#pragma unroll
            for (int j = 0; j < 4; ++j) { float s, c; sincos_rev(pos * fr_rev[j], s, c);
              const float x1 = v0[j], x2 = v1[j]; v0[j] = x1 * c - x2 * s; v1[j] = x2 * c + x1 * s; }
          }
          bf16_t* rowp = O + (size_t)row * 1536 + col0;
          u32x2 w0, w1; w0.x = pk_bf16(v0[0], v0[1]); w0.y = pk_bf16(v0[2], v0[3]); w1.x = pk_bf16(v1[0], v1[1]); w1.y = pk_bf16(v1[2], v1[3]);
          *(u32x2*)(rowp) = w0; *(u32x2*)(rowp + 16) = w1;
        }
    }
  }
};
template <bool XIN_F32>
struct EpiResid {
  static constexpr bool PERM = true;
  const void* xin; bf16_t* xout; const float* gate;
  __device__ __forceinline__ void operator()(const f32x4 (&acc)[2][2][4][2], const Unit& u, int wr, int wc, int fr, int fq) const {
    const int row0 = u.pm * BM + wr * 64 + fr, col0 = u.pn * BM + wc * 32 + 8 * fq;
    const float* gp = gate + (size_t)((u.pm * BM) / SEQ) * 6144 + col0;
    f32x4 gv[2][2];
#pragma unroll
    for (int bj = 0; bj < 2; ++bj)
#pragma unroll
      for (int n = 0; n < 2; ++n) gv[bj][n] = *(const f32x4*)(gp + bj * HALF + n * 4);
    f32x4 xa[2][2], xb[2][2];
#define EPR_LOAD(X, g) do { const size_t off_ = (size_t)(row0 + ((g) >> 2) * HALF + ((g) & 3) * 16) * DM + col0; \
      _Pragma("unroll") for (int bj = 0; bj < 2; ++bj) { \
        if (XIN_F32) { X[bj][0] = *(const f32x4*)((const float*)xin + off_ + bj * HALF); X[bj][1] = *(const f32x4*)((const float*)xin + off_ + bj * HALF + 4); } \
        else { const u32x4 t_ = *(const u32x4*)((const bf16_t*)xin + off_ + bj * HALF); X[bj][0] = (f32x4){bf_lo(t_.x), bf_hi(t_.x), bf_lo(t_.y), bf_hi(t_.y)}; X[bj][1] = (f32x4){bf_lo(t_.z), bf_hi(t_.z), bf_lo(t_.w), bf_hi(t_.w)}; } } } while (0)
#define EPR_STORE(X, g) do { const size_t off_ = (size_t)(row0 + ((g) >> 2) * HALF + ((g) & 3) * 16) * DM + col0; \
      _Pragma("unroll") for (int bj = 0; bj < 2; ++bj) { const f32x4 v0_ = X[bj][0] + gv[bj][0] * acc[(g) >> 2][bj][(g) & 3][0], v1_ = X[bj][1] + gv[bj][1] * acc[(g) >> 2][bj][(g) & 3][1]; \
        u32x4 w_; w_.x = pk_bf16(v0_[0], v0_[1]); w_.y = pk_bf16(v0_[2], v0_[3]); w_.z = pk_bf16(v1_[0], v1_[1]); w_.w = pk_bf16(v1_[2], v1_[3]); *(u32x4*)(xout + off_ + bj * HALF) = w_; } } while (0)
    EPR_LOAD(xa, 0); EPR_LOAD(xb, 1);
    EPR_STORE(xa, 0); EPR_LOAD(xa, 2); EPR_STORE(xb, 1); EPR_LOAD(xb, 3);
    EPR_STORE(xa, 2); EPR_LOAD(xa, 4); EPR_STORE(xb, 3); EPR_LOAD(xb, 5);
    EPR_STORE(xa, 4); EPR_LOAD(xa, 6); EPR_STORE(xb, 5); EPR_LOAD(xb, 7);
    EPR_STORE(xa, 6); EPR_STORE(xb, 7);
#undef EPR_LOAD
#undef EPR_STORE
  }
};
struct EpiSwiglu {
  static constexpr bool PERM = true;
  bf16_t* O; int ldc;
  __device__ __forceinline__ void operator()(const f32x4 (&acc)[2][2][4][2], const Unit& u, int wr, int wc, int fr, int fq) const {
    const int row0 = u.pm * BM + wr * 64 + fr, col0 = u.pn * HALF + wc * 32 + 8 * fq;
#pragma unroll
    for (int ai = 0; ai < 2; ++ai)
#pragma unroll
      for (int m = 0; m < 4; ++m) { float r[8];
#pragma unroll
        for (int n = 0; n < 2; ++n) { const f32x4 g = acc[ai][0][m][n], up = acc[ai][1][m][n];
#pragma unroll
          for (int j = 0; j < 4; ++j) r[4 * n + j] = g[j] * __builtin_amdgcn_rcpf(1.0f + __builtin_amdgcn_exp2f(-g[j] * 1.4426950408889634f)) * up[j]; }
        u32x4 w; w.x = pk_bf16(r[0], r[1]); w.y = pk_bf16(r[2], r[3]); w.z = pk_bf16(r[4], r[5]); w.w = pk_bf16(r[6], r[7]);
        *(u32x4*)(O + (size_t)(row0 + ai * HALF + m * 16) * ldc + col0) = w; }
  }
};
struct EpiConvIn {
  static constexpr bool PERM = true;
  bf16_t* CV; bf16_t* BG;
  __device__ __forceinline__ void operator()(const f32x4 (&acc)[2][2][4][2], const Unit& u, int wr, int wc, int fr, int fq) const {
    const int row0 = u.pm * BM + wr * 64 + fr;
#pragma unroll
    for (int ai = 0; ai < 2; ++ai)
#pragma unroll
      for (int m = 0; m < 4; ++m) { const size_t row = (size_t)(row0 + ai * HALF + m * 16);
        if (u.pn < 8) { const f32x4 r0 = acc[ai][0][m][0] * acc[ai][1][m][0], r1 = acc[ai][0][m][1] * acc[ai][1][m][1];
          u32x4 w; w.x = pk_bf16(r0[0], r0[1]); w.y = pk_bf16(r0[2], r0[3]); w.z = pk_bf16(r1[0], r1[1]); w.w = pk_bf16(r1[2], r1[3]);
          *(u32x4*)(CV + row * DM + u.pn * HALF + wc * 32 + 8 * fq) = w;
        } else {
#pragma unroll
          for (int bj = 0; bj < 2; ++bj) { const f32x4 a = acc[ai][bj][m][0], b = acc[ai][bj][m][1];
            u32x4 w; w.x = pk_bf16(a[0], a[1]); w.y = pk_bf16(a[2], a[3]); w.z = pk_bf16(b[0], b[1]); w.w = pk_bf16(b[2], b[3]);
            *(u32x4*)(BG + row * DM + (u.pn - 8) * BM + bj * HALF + wc * 32 + 8 * fq) = w; } } }
  }
};
}

namespace att {
constexpr int NW = 8, QBLK = 32, KVBLK = 64;
constexpr int LDQ = 1536, LDK = DQK, LDO = 1024;
constexpr float SCALE = 0.07216878364870322f;
constexpr float THR = 8.f;
constexpr int SHM_V = KVBLK * 128 * 2, SHM_K = KVBLK * DQK * 2;
constexpr int SHM_ATTN = 2 * SHM_V + 2 * SHM_K + NW * 64 * 4;
#define KSWZ(row, colB) ((row) * 384 + ((colB) ^ ((((row) >> 1) & 7) << 4)))
#define SBAR() __builtin_amdgcn_sched_barrier(0)
__device__ __forceinline__ int crow(int r, int hi) { return (r & 3) + 8 * (r >> 2) + 4 * hi; }
__device__ __forceinline__ unsigned cvtpk(float lo, float hi) { return pk_bf16(lo, hi); }

__device__ __forceinline__ void partialSM(f32x16& p0, f32x16& p1, float& m_reg, float& mn, float& alpha) {
  constexpr float C = SCALE * 1.4426950408889634f;
  float pmax = p0[0];
#pragma unroll
  for (int r = 1; r < 16; ++r) pmax = fmaxf(pmax, p0[r]);
#pragma unroll
  for (int r = 0; r < 16; ++r) pmax = fmaxf(pmax, p1[r]);
  { auto rr = __builtin_amdgcn_permlane32_swap(__float_as_uint(pmax), __float_as_uint(pmax), false, false);
    pmax = fmaxf(__uint_as_float(rr[0]), __uint_as_float(rr[1])); }
  if (__builtin_expect(__all(pmax - m_reg <= THR / SCALE), 1)) { mn = m_reg; alpha = 1.f; }
  else { mn = fmaxf(m_reg, pmax); alpha = __builtin_amdgcn_exp2f((m_reg - mn) * C); m_reg = mn; }
  float mnC = -mn * C;
#pragma unroll
  for (int r = 0; r < 16; ++r) p0[r] = fmaf(p0[r], C, mnC);
#pragma unroll
  for (int r = 0; r < 16; ++r) p1[r] = fmaf(p1[r], C, mnC);
#pragma unroll
  for (int r = 0; r < 16; ++r) p0[r] = __builtin_amdgcn_exp2f(p0[r]);
}
__device__ __forceinline__ void finishSM(f32x16& p0, f32x16& p1, float alpha, float& l_reg, bf16x8& pa0, bf16x8& pa1, bf16x8& pa2, bf16x8& pa3) {
#pragma unroll
  for (int r = 0; r < 16; ++r) p1[r] = __builtin_amdgcn_exp2f(p1[r]);
  float ps = 0;
#pragma unroll
  for (int r = 0; r < 16; ++r) ps += p0[r];
#pragma unroll
  for (int r = 0; r < 16; ++r) ps += p1[r];
  { auto rr = __builtin_amdgcn_permlane32_swap(__float_as_uint(ps), __float_as_uint(ps), false, false);
    ps = __uint_as_float(rr[0]) + __uint_as_float(rr[1]); }
  l_reg = l_reg * alpha + ps;
#define PK4(P, BASE, OUT) do { unsigned a0 = cvtpk(P[BASE + 0], P[BASE + 1]), a1 = cvtpk(P[BASE + 2], P[BASE + 3]);   \
    unsigned b0 = cvtpk(P[BASE + 4], P[BASE + 5]), b1 = cvtpk(P[BASE + 6], P[BASE + 7]);                              \
    auto r0 = __builtin_amdgcn_permlane32_swap(a0, b0, false, false); auto r1 = __builtin_amdgcn_permlane32_swap(a1, b1, false, false); \
    u32x4 w = {r0[0], r1[0], r0[1], r1[1]}; OUT = *reinterpret_cast<bf16x8*>(&w); } while (0)
  PK4(p0, 0, pa0); PK4(p0, 8, pa1); PK4(p1, 0, pa2); PK4(p1, 8, pa3);
#undef PK4
}
__device__ __forceinline__ void qkt(f32x16& p0, f32x16& p1, const char* Ks, const bf16x8* qr, int r32, int hi) {
  p0 = f32x16{}; p1 = f32x16{};
#pragma unroll
  for (int d0 = 0; d0 < 12; ++d0) { int cb = (d0 * 16 + hi * 8) * 2;
    bf16x8 b0 = *reinterpret_cast<const bf16x8*>(Ks + KSWZ(r32, cb));
    bf16x8 b1 = *reinterpret_cast<const bf16x8*>(Ks + KSWZ(32 + r32, cb));
    p0 = __builtin_amdgcn_mfma_f32_32x32x16_bf16(b0, qr[d0], p0, 0, 0, 0);
    p1 = __builtin_amdgcn_mfma_f32_32x32x16_bf16(b1, qr[d0], p1, 0, 0, 0);
    if ((d0 & 3) == 3 && d0 != 11) SBAR(); }
}
__device__ __forceinline__ int v_st(int k, int c) { const int kk = (k & ~0xC) | ((k & 4) << 1) | ((k & 8) >> 1); return ((kk >> 3) * 4 + (c >> 5)) * 512 + ((kk & 7) * 32 + (c & 31)) * 2; }
__device__ __forceinline__ int v_rd_base(int lane) { return ((lane & 3) << 3) | (((lane >> 2) & 3) << 6) | (((lane >> 4) & 1) << 5) | (((lane >> 5) & 1) << 8); }
constexpr int v_rd_off(int d0, int ks, int half) { return d0 * 512 + ks * 4096 + half * 2048; }
template <int OFF> __device__ __forceinline__ s16x4 tr_read(int vb) {
  s16x4 r; asm volatile("ds_read_b64_tr_b16 %0, %1 offset:%2" : "=&v"(r) : "v"(vb), "i"(OFF) : "memory"); return r;
}
template <int D0> __device__ __forceinline__ void pv_one(f32x16& od, int vb, bf16x8 pa0, bf16x8 pa1, bf16x8 pa2, bf16x8 pa3) {
  const s16x4 l0 = tr_read<v_rd_off(D0, 0, 0)>(vb), h0 = tr_read<v_rd_off(D0, 0, 1)>(vb), l1 = tr_read<v_rd_off(D0, 1, 0)>(vb), h1 = tr_read<v_rd_off(D0, 1, 1)>(vb);
  const s16x4 l2 = tr_read<v_rd_off(D0, 2, 0)>(vb), h2 = tr_read<v_rd_off(D0, 2, 1)>(vb), l3 = tr_read<v_rd_off(D0, 3, 0)>(vb), h3 = tr_read<v_rd_off(D0, 3, 1)>(vb);
  asm volatile("s_waitcnt lgkmcnt(0)" ::: "memory"); SBAR();
#define PK(L, H) (bf16x8){L[0], L[1], L[2], L[3], H[0], H[1], H[2], H[3]}
  od = __builtin_amdgcn_mfma_f32_32x32x16_bf16(pa0, PK(l0, h0), od, 0, 0, 0);
  od = __builtin_amdgcn_mfma_f32_32x32x16_bf16(pa1, PK(l1, h1), od, 0, 0, 0);
  od = __builtin_amdgcn_mfma_f32_32x32x16_bf16(pa2, PK(l2, h2), od, 0, 0, 0);
  od = __builtin_amdgcn_mfma_f32_32x32x16_bf16(pa3, PK(l3, h3), od, 0, 0, 0);
#undef PK
}
__device__ __forceinline__ void pv_d0(f32x16* o, int vb, bf16x8 pa0, bf16x8 pa1, bf16x8 pa2, bf16x8 pa3) {
  pv_one<0>(o[0], vb, pa0, pa1, pa2, pa3); pv_one<1>(o[1], vb, pa0, pa1, pa2, pa3); pv_one<2>(o[2], vb, pa0, pa1, pa2, pa3); pv_one<3>(o[3], vb, pa0, pa1, pa2, pa3);
}

constexpr int SLOT = SHM_K + SHM_V;
constexpr int NTILE = SKV / KVBLK;
static_assert(NTILE % 6 == 0, "tile loop is unrolled by 6");
constexpr int ATT_WS = 3 * SLOT;
__device__ __forceinline__ void attn_unit(int wsg, const bf16_t* __restrict__ Qb, const bf16_t* __restrict__ Kh, bf16_t* __restrict__ Ob, LAS unsigned char* ldsl) {
  const int tid = opaque_tid(wsg), wid = __builtin_amdgcn_readfirstlane(tid >> 6), lane = tid & 63, r32 = lane & 31, hi = lane >> 5;
  LAS float* ws = (LAS float*)(ldsl + ATT_WS) + wid * 64; LAS float* li_l = ws; LAS float* al_l = ws + 32;
  float m_reg = -1e30f, l_reg = 0; f32x16 o[4] = {}; bf16x8 qr[8];
  const bf16_t* Qw = Qb + (long)(wid * QBLK + r32) * LDQ + hi * 8;
#pragma unroll
  for (int d0 = 0; d0 < 8; ++d0) qr[d0] = *reinterpret_cast<const bf16x8*>(Qw + d0 * 16);
  LAS bf16x8* qlds = (LAS bf16x8*)(ldsl + ATT_WS + 2048 + wid * 4096) + lane;
#pragma unroll
  for (int i = 0; i < 4; ++i) qlds[i * 64] = *reinterpret_cast<const bf16x8*>(Qw + (8 + i) * 16);
  unsigned soff[5];
#pragma unroll
  for (int i = 0; i < 5; ++i) { const int ob = (wid * 5 + i) * 1024 + lane * 16;
    if (ob < SHM_K) { const int row = ob / 384, cph = ob % 384; soff[i] = (unsigned)(row * 384 + (cph ^ (((row >> 1) & 7) << 4))); }
    else { const int o2 = ob - SHM_K, st = o2 >> 9, wi = o2 & 511, kk = (st >> 2) * 8 + (wi >> 6), cc = (wi & 63) >> 1, cg = st & 3;
      const int k = (kk & ~0xC) | ((kk & 4) << 1) | ((kk & 8) >> 1); soff[i] = (unsigned)(k * 384 + (cg * 32 + cc) * 2); } }
  const int tsw = (hi * 16) ^ (((r32 >> 1) & 7) << 4);
  int kbs[4];
#pragma unroll
  for (int m = 0; m < 4; ++m) kbs[m] = r32 * 384 + ((m * 32) ^ tsw);
  const int vb0 = (int)(uintptr_t)(ldsl + SHM_K) + v_rd_base(lane);
#define ISSUE(SI, TI) do { const char* gb_ = (const char*)Kh + (size_t)(TI) * (KVBLK * 384); asm volatile("" : "+s"(gb_)); \
    _Pragma("unroll") for (int i_ = 0; i_ < 5; ++i_) __builtin_amdgcn_global_load_lds((const unsigned*)(gb_ + soff[i_]), (LAS unsigned*)(ldsl + (SI) * SLOT + (wid * 5 + i_) * 1024), 16, 0, 0); } while (0)
#define WAITBAR() asm volatile("s_waitcnt vmcnt(0) lgkmcnt(0)\n\ts_barrier" ::: "memory")
#define RESC(a) do { if (__any((a) < 1.f)) { if (hi == 0) al_l[r32] = (a); asm volatile("s_waitcnt lgkmcnt(0)" ::: "memory"); \
    _Pragma("unroll") for (int d = 0; d < 4; ++d) _Pragma("unroll") for (int r = 0; r < 16; ++r) o[d][r] *= al_l[crow(r, hi)]; } } while (0)
#define KLD(d0, SK, H) (*(const LAS bf16x8*)(ldsl + kbs[(d0) & 3] + ((SK) * SLOT + ((d0) >> 2) * 128 + (H) * (32 * 384))))
#define QKT(P0, P1, SK) do { P0 = f32x16{}; P1 = f32x16{}; \
    _Pragma("unroll") for (int d0 = 0; d0 < 12; ++d0) { \
      const bf16x8 b0_ = KLD(d0, SK, 0); const bf16x8 b1_ = KLD(d0, SK, 1); \
      bf16x8 qf_; if (d0 < 8) qf_ = qr[d0 < 8 ? d0 : 0]; else qf_ = qlds[(d0 - 8) * 64]; \
      P0 = __builtin_amdgcn_mfma_f32_32x32x16_bf16(b0_, qf_, P0, 0, 0, 0); \
      P1 = __builtin_amdgcn_mfma_f32_32x32x16_bf16(b1_, qf_, P1, 0, 0, 0); } } while (0)
#define QKT_SCHED() do { __builtin_amdgcn_sched_group_barrier(0x100, 2, 0); \
    _Pragma("unroll") for (int d0 = 0; d0 < 12; ++d0) { \
      __builtin_amdgcn_sched_group_barrier(0x008, 1, 0); __builtin_amdgcn_sched_group_barrier(0x400, 1, 0); __builtin_amdgcn_sched_group_barrier(0x002, 4, 0); \
      if (d0 < 7) __builtin_amdgcn_sched_group_barrier(0x100, 2, 0); else if (d0 < 11) __builtin_amdgcn_sched_group_barrier(0x100, 3, 0); \
      __builtin_amdgcn_sched_group_barrier(0x008, 1, 0); __builtin_amdgcn_sched_group_barrier(0x400, 1, 0); __builtin_amdgcn_sched_group_barrier(0x002, 4, 0); } } while (0)
#define PSM_A(P0, P1) do { pmax_ = P0[0]; _Pragma("unroll") for (int r = 1; r < 16; ++r) pmax_ = fmaxf(pmax_, P0[r]); _Pragma("unroll") for (int r = 0; r < 16; ++r) pmax_ = fmaxf(pmax_, P1[r]); } while (0)
#define PSM_B(P0, P1, MN, AL) do { constexpr float C_ = SCALE * 1.4426950408889634f; \
    { auto rr_ = __builtin_amdgcn_permlane32_swap(__float_as_uint(pmax_), __float_as_uint(pmax_), false, false); pmax_ = fmaxf(__uint_as_float(rr_[0]), __uint_as_float(rr_[1])); } \
    const bool keep_ = __all(pmax_ - m_reg <= THR / SCALE); const float mc_ = fmaxf(m_reg, pmax_); const float a2_ = __builtin_amdgcn_exp2f((m_reg - mc_) * C_); \
    MN = keep_ ? m_reg : mc_; AL = keep_ ? 1.f : a2_; m_reg = MN; mnC_ = -MN * C_; \
    _Pragma("unroll") for (int r = 0; r < 16; ++r) P0[r] = fmaf(P0[r], C_, mnC_); } while (0)
#define PSM_C(P0, P1) do { constexpr float C_ = SCALE * 1.4426950408889634f; \
    _Pragma("unroll") for (int r = 0; r < 16; ++r) P1[r] = fmaf(P1[r], C_, mnC_); \
    _Pragma("unroll") for (int r = 0; r < 4; ++r) P0[r] = __builtin_amdgcn_exp2f(P0[r]); } while (0)
#define PSM_D(P0) do { _Pragma("unroll") for (int r = 4; r < 16; ++r) P0[r] = __builtin_amdgcn_exp2f(P0[r]); } while (0)
#define HALF(PX0, PX1, MNX, ALX, PY0, PY1, ALY, SK, SV, SI, TI) do { \
    WAITBAR(); \
    if ((TI) < NTILE) ISSUE(SI, TI); \
    SBAR(); QKT(PX0, PX1, SK); \
    finishSM(PY0, PY1, ALY, l_reg, pa0, pa1, pa2, pa3); QKT_SCHED(); SBAR(); \
    { float pmax_, mnC_; const int vb_ = vb0 + (SV) * SLOT; \
      pv_one<0>(o[0], vb_, pa0, pa1, pa2, pa3); PSM_A(PX0, PX1); \
      pv_one<1>(o[1], vb_, pa0, pa1, pa2, pa3); PSM_B(PX0, PX1, MNX, ALX); \
      pv_one<2>(o[2], vb_, pa0, pa1, pa2, pa3); PSM_C(PX0, PX1); \
      pv_one<3>(o[3], vb_, pa0, pa1, pa2, pa3); PSM_D(PX0); asm volatile("" : "+v"(PX0), "+v"(PX1)); } \
    RESC(ALX); } while (0)
  f32x16 pA0, pA1, pB0, pB1; float mnA, mnB, alA, alB; bf16x8 pa0, pa1, pa2, pa3;
  ISSUE(0, 0); WAITBAR(); ISSUE(1, 1);
  QKT(pA0, pA1, 0); partialSM(pA0, pA1, m_reg, mnA, alA);
  for (int j = 1; j + 5 < NTILE; j += 6) {
    HALF(pB0, pB1, mnB, alB, pA0, pA1, alA, 1, 0, 2, j + 1);
    HALF(pA0, pA1, mnA, alA, pB0, pB1, alB, 2, 1, 0, j + 2);
    HALF(pB0, pB1, mnB, alB, pA0, pA1, alA, 0, 2, 1, j + 3);
    HALF(pA0, pA1, mnA, alA, pB0, pB1, alB, 1, 0, 2, j + 4);
    HALF(pB0, pB1, mnB, alB, pA0, pA1, alA, 2, 1, 0, j + 5);
    HALF(pA0, pA1, mnA, alA, pB0, pB1, alB, 0, 2, 1, j + 6);
  }
  HALF(pB0, pB1, mnB, alB, pA0, pA1, alA, 1, 0, 2, NTILE - 4);
  HALF(pA0, pA1, mnA, alA, pB0, pB1, alB, 2, 1, 0, NTILE - 3);
  HALF(pB0, pB1, mnB, alB, pA0, pA1, alA, 0, 2, 1, NTILE - 2);
  HALF(pA0, pA1, mnA, alA, pB0, pB1, alB, 1, 0, 2, NTILE - 1);
  HALF(pB0, pB1, mnB, alB, pA0, pA1, alA, 2, 1, 0, NTILE);
  finishSM(pB0, pB1, alB, l_reg, pa0, pa1, pa2, pa3); SBAR();
  pv_d0(o, vb0 + 2 * SLOT, pa0, pa1, pa2, pa3);
  if (hi == 0) li_l[r32] = l_reg; asm volatile("s_waitcnt lgkmcnt(0)" ::: "memory");
  bf16_t* Ow = Ob + (long)(wid * QBLK) * LDO;
#pragma unroll
  for (int r = 0; r < 16; ++r) { const int orow = crow(r, hi); const float rli = __builtin_amdgcn_rcpf(li_l[orow]);
#pragma unroll
    for (int d0 = 0; d0 < 4; ++d0) Ow[(long)orow * LDO + d0 * 32 + r32] = (bf16_t)(pk_bf16(o[d0][r] * rli, 0.f) & 0xffffu); }
#undef ISSUE
#undef WAITBAR
#undef RESC
#undef QKT
#undef PSM_A
#undef PSM_B
#undef PSM_C
#undef PSM_D
#undef QKT_SCHED
#undef KLD
#undef HALF
}
}

struct Params {
  const float* x; const float* c; const float* ctx; const float* c_ctx; const float* ada_w; const float* ada_b; const float* norm_mix; const float* norm_ffn;
  const float* w_dq; const float* q_norm; const float* w_uq; const float* w_dkv; const float* kv_norm; const float* w_ukv; const float* w_o;
  const float* conv_w_in; const float* conv_w; const float* conv_w_out; const float* w_gate; const float* w_up; const float* w_down; const float* final_norm;
  float* out; unsigned char* ws;
};

template <bool FINAL, bool SRC16>
__device__ __forceinline__ void norm_rows(int wsg, const float* src_lat, const float* src_ctx, const bf16_t* src16, int nrows, const float* w, const float* mod, int sh_off, int sc_off, bf16_t* H, float* outf) {
  const int tid_ = opaque_tid(wsg); const int lane = tid_ & 63, wv = blockIdx.x * 8 + (tid_ >> 6), nw = gridDim.x * 8;
  f32x4 wv4[4];
#pragma unroll
  for (int i = 0; i < 2; ++i) { wv4[2 * i] = *(const f32x4*)(w + i * 512 + lane * 8); wv4[2 * i + 1] = *(const f32x4*)(w + i * 512 + lane * 8 + 4); }
  for (int row = wv; row < nrows; row += nw) {
    f32x4 v[4]; float ss = 0.f;
    if (SRC16) { const bf16_t* xp = src16 + (size_t)row * DM;
#pragma unroll
      for (int i = 0; i < 2; ++i) { const u32x4 t = *(const u32x4*)(xp + i * 512 + lane * 8); v[2 * i] = (f32x4){bf_lo(t.x), bf_hi(t.x), bf_lo(t.y), bf_hi(t.y)}; v[2 * i + 1] = (f32x4){bf_lo(t.z), bf_hi(t.z), bf_lo(t.w), bf_hi(t.w)}; }
    } else { const float* xp = row < MLAT ? src_lat + (size_t)row * DM : src_ctx + (size_t)(row - MLAT) * DM;
#pragma unroll
      for (int i = 0; i < 2; ++i) { v[2 * i] = *(const f32x4*)(xp + i * 512 + lane * 8); v[2 * i + 1] = *(const f32x4*)(xp + i * 512 + lane * 8 + 4); } }
#pragma unroll
    for (int i = 0; i < 4; ++i) ss += v[i][0] * v[i][0] + v[i][1] * v[i][1] + v[i][2] * v[i][2] + v[i][3] * v[i][3];
    ss = wave_sum(ss);
    const float rstd = rsqrtf(ss * (1.0f / DM) + NORM_EPS);
    if (FINAL) {
#pragma unroll
      for (int i = 0; i < 2; ++i) { *(f32x4*)(outf + (size_t)row * DM + i * 512 + lane * 8) = v[2 * i] * rstd * wv4[2 * i]; *(f32x4*)(outf + (size_t)row * DM + i * 512 + lane * 8 + 4) = v[2 * i + 1] * rstd * wv4[2 * i + 1]; }
    } else {
      const int mr = row < MLAT ? row / SEQ : 4;
      const float* mp = mod + (size_t)mr * 6144;
#pragma unroll
      for (int i = 0; i < 2; ++i) { const int c = i * 512 + lane * 8;
        const f32x4 sh0 = *(const f32x4*)(mp + sh_off + c), sh1 = *(const f32x4*)(mp + sh_off + c + 4), sc0 = *(const f32x4*)(mp + sc_off + c), sc1 = *(const f32x4*)(mp + sc_off + c + 4);
        const f32x4 h0 = v[2 * i] * rstd * wv4[2 * i] * (1.0f + sc0) + sh0, h1 = v[2 * i + 1] * rstd * wv4[2 * i + 1] * (1.0f + sc1) + sh1;
        u32x4 o; o.x = pk_bf16(h0[0], h0[1]); o.y = pk_bf16(h0[2], h0[3]); o.z = pk_bf16(h1[0], h1[1]); o.w = pk_bf16(h1[2], h1[3]);
        *(u32x4*)(H + (size_t)row * DM + c) = o; }
    }
  }
}

typedef const __attribute__((address_space(4))) Params* ParamsK;
__device__ __forceinline__ ParamsK kparams() { auto kp = __builtin_amdgcn_kernarg_segment_ptr(); asm volatile("" : "+s"(kp)); return (ParamsK)kp; }
#define WSP(T, OFF) ((T*)(q->ws + (OFF)))

__device__ __forceinline__ void phase_adaln(int wsg, unsigned char* shm) {
  ParamsK q = kparams();
  const int tid = opaque_tid(wsg), lane = tid & 63, wid = tid >> 6;
  const int G = gridDim.x, bid = blockIdx.x;
  float* lds_f = (float*)shm;
  float* mod = WSP(float, WS_MOD);
  for (int it = bid; it < 2 * 96; it += G) {
    const int layer = it / 96, n0 = (it % 96) * 64;
    float* sv = lds_f;
    float* part = lds_f + 5 * 1024;
    const float* cp = q->c; const float* ccp = q->c_ctx;
    for (int e = tid; e < 5 * 1024; e += 512) { const int r = e >> 10, k = e & 1023; const float cv = r < 4 ? cp[r * DM + k] : ccp[k]; sv[e] = silu_f(cv); }
    __syncthreads();
    float a0 = 0.f, a1 = 0.f, a2 = 0.f, a3 = 0.f, a4 = 0.f;
    const float* wp = q->ada_w + (size_t)layer * DM * 6144 + n0 + lane;
    for (int k = wid * 128; k < wid * 128 + 128; ++k) { const float wv = wp[(size_t)k * 6144];
      a0 += sv[k] * wv; a1 += sv[1024 + k] * wv; a2 += sv[2048 + k] * wv; a3 += sv[3072 + k] * wv; a4 += sv[4096 + k] * wv; }
    part[(wid * 5 + 0) * 64 + lane] = a0; part[(wid * 5 + 1) * 64 + lane] = a1; part[(wid * 5 + 2) * 64 + lane] = a2; part[(wid * 5 + 3) * 64 + lane] = a3; part[(wid * 5 + 4) * 64 + lane] = a4;
    __syncthreads();
    if (tid < 320) { const int r = tid >> 6, l = tid & 63; float s = 0.f;
#pragma unroll
      for (int w8 = 0; w8 < 8; ++w8) s += part[(w8 * 5 + r) * 64 + l];
      mod[((size_t)layer * 5 + r) * 6144 + n0 + l] = s + q->ada_b[layer * 6144 + n0 + l]; }
    __syncthreads();
  }
}
__device__ __forceinline__ void phase_prologue(int wsg, unsigned char* shm) {
  ParamsK q = kparams();
  const int tid = opaque_tid(wsg);
  const int G = gridDim.x, bid = blockIdx.x;
  float* lds_f = (float*)shm;
  {
    constexpr int T_QKVA = 8 * 16, T_GU = 88 * 16, T_D = 16 * 44, T_IN = 48 * 16, T_OUT = 16 * 16;
    constexpr int T_TOTAL = T_QKVA + 2 * T_GU + 2 * T_D + T_IN + T_OUT;
    const int t = tid, chunk = (t & 15) >> 2, cc = (t & 3) * 4;
    struct TItem { const float* sp; int ld; bf16_t* dst; int Kdst; int n0, k0; };
    auto decode = [&](int it) -> TItem { TItem r; int i = it;
      if (i < T_QKVA) { const int tn = i / 16, tk = i % 16, n16 = tn * 64 + 16 * chunk; r.n0 = tn * 64; r.k0 = tk * 64; r.dst = WSP(bf16_t, WS_WQKVA); r.Kdst = DM;
        if (tn < 4) { r.sp = q->w_dq + n16; r.ld = 256; } else { r.sp = n16 < 448 ? q->w_dkv + (n16 - 256) : (const float*)nullptr; r.ld = 192; } return r; }
      i -= T_QKVA;
      for (int layer = 0; layer < 2; ++layer) {
        if (i < T_GU) { const int tn = i / 16, tk = i % 16, n16 = tn * 64 + 16 * chunk; r.n0 = tn * 64; r.k0 = tk * 64; r.dst = WSP(bf16_t, layer ? WS_WGU1 : WS_WGU0); r.Kdst = DM; r.ld = DFF;
          r.sp = ((n16 & 128) ? q->w_up : q->w_gate) + (size_t)layer * DM * DFF + (n16 >> 8) * 128 + (n16 & 127); return r; }
        i -= T_GU;
        if (i < T_D) { const int tn = i / 44, tk = i % 44, n16 = tn * 64 + 16 * chunk; r.n0 = tn * 64; r.k0 = tk * 64; r.dst = WSP(bf16_t, layer ? WS_WD1 : WS_WD0); r.Kdst = DFF; r.ld = DM;
          r.sp = q->w_down + (size_t)layer * DFF * DM + n16; return r; }
        i -= T_D;
      }
      if (i < T_IN) { const int tn = i / 16, tk = i % 16, n16 = tn * 64 + 16 * chunk; r.n0 = tn * 64; r.k0 = tk * 64; r.dst = WSP(bf16_t, WS_WIN); r.Kdst = DM; r.ld = 3 * DM;
        if (n16 < 2048) r.sp = q->conv_w_in + ((n16 & 128) ? 2048 : 1024) + (n16 >> 8) * 128 + (n16 & 127); else r.sp = q->conv_w_in + (n16 - 2048); return r; }
      i -= T_IN;
      { const int tn = i / 16, tk = i % 16, n16 = tn * 64 + 16 * chunk; r.n0 = tn * 64; r.k0 = tk * 64; r.dst = WSP(bf16_t, WS_WOUT); r.Kdst = DM; r.ld = DM; r.sp = q->conv_w_out + n16; return r; }
    };
    auto load2 = [&](const TItem& I, f32x4& v0, f32x4& v1) { v0 = (f32x4){0.f, 0.f, 0.f, 0.f}; v1 = v0;
      if (I.sp) { v0 = *(const f32x4*)(I.sp + (size_t)(I.k0 + (t >> 4)) * I.ld + cc); v1 = *(const f32x4*)(I.sp + (size_t)(I.k0 + (t >> 4) + 32) * I.ld + cc); } };
    int it = bid;
    if (it < T_TOTAL) {
      TItem cur = decode(it); f32x4 v0, v1; load2(cur, v0, v1);
      for (;;) {
        const int nit = it + G; const bool has = nit < T_TOTAL; TItem nxt = cur; f32x4 n0v = v0, n1v = v1;
        if (has) { nxt = decode(nit); load2(nxt, n0v, n1v); }
        { float* lp = lds_f + (t >> 4) * 65 + chunk * 16 + cc; lp[0] = v0[0]; lp[1] = v0[1]; lp[2] = v0[2]; lp[3] = v0[3];
          lp += 32 * 65; lp[0] = v1[0]; lp[1] = v1[1]; lp[2] = v1[2]; lp[3] = v1[3]; }
        __syncthreads();
        { const int n = t >> 3, kk = (t & 7) * 8; float a[8];
#pragma unroll
          for (int j = 0; j < 8; ++j) a[j] = lds_f[(kk + j) * 65 + n];
          u32x4 w; w.x = pk_bf16(a[0], a[1]); w.y = pk_bf16(a[2], a[3]); w.z = pk_bf16(a[4], a[5]); w.w = pk_bf16(a[6], a[7]);
          *(u32x4*)(cur.dst + (size_t)(cur.n0 + n) * cur.Kdst + cur.k0 + kk) = w; }
        __syncthreads();
        if (!has) break;
        cur = nxt; v0 = n0v; v1 = n1v; it = nit;
      }
    }
  }
  const int gt = bid * 512 + tid, nthr = G * 512;
  { const float* w_ukv = q->w_ukv; const float* w_uq = q->w_uq; bf16_t* Wuq = WSP(bf16_t, WS_WUQ);
  for (int idx = gt; idx < 1536 * 32; idx += nthr) {
    const int n = idx >> 5, jg = (idx & 31) * 8, h = n / 192, c = n % 192; float a[8];
#pragma unroll
    for (int i = 0; i < 8; ++i) a[i] = 0.f;
    if (c < 128) { const float* kr = w_ukv + (size_t)c * 2048 + h * 256;
      for (int d = 0; d < 128; d += 4) { const f32x4 kv = *(const f32x4*)(kr + d);
#pragma unroll
        for (int i = 0; i < 8; ++i) { const f32x4 qv = *(const f32x4*)(w_uq + (size_t)(jg + i) * 1536 + h * 192 + d); a[i] += qv[0] * kv[0] + qv[1] * kv[1] + qv[2] * kv[2] + qv[3] * kv[3]; } }
    } else {
#pragma unroll
      for (int i = 0; i < 8; ++i) a[i] = w_uq[(size_t)(jg + i) * 1536 + n];
    }
    u32x4 w; w.x = pk_bf16(a[0], a[1]); w.y = pk_bf16(a[2], a[3]); w.z = pk_bf16(a[4], a[5]); w.w = pk_bf16(a[6], a[7]);
    *(u32x4*)(Wuq + (size_t)n * 256 + jg) = w;
  } }
  { const float* w_ukv = q->w_ukv; const float* w_o = q->w_o; bf16_t* Wo = WSP(bf16_t, WS_WO);
  for (int idx = gt; idx < 1024 * 128; idx += nthr) {
    const int n = idx & 1023, kg = __builtin_amdgcn_readfirstlane(idx >> 10), h = kg >> 4, c0 = (kg & 15) * 8; float a[8];
#pragma unroll
    for (int i = 0; i < 8; ++i) a[i] = 0.f;
    const float* wop = w_o + (size_t)(h * 128) * DM + n; const float* vr = w_ukv + (size_t)c0 * 2048 + h * 256 + 128;
    for (int d = 0; d < 128; ++d) { const float wv = wop[(size_t)d * DM];
#pragma unroll
      for (int i = 0; i < 8; ++i) a[i] += vr[(size_t)i * 2048 + d] * wv; }
    u32x4 w; w.x = pk_bf16(a[0], a[1]); w.y = pk_bf16(a[2], a[3]); w.z = pk_bf16(a[4], a[5]); w.w = pk_bf16(a[6], a[7]);
    *(u32x4*)(Wo + (size_t)n * DM + h * 128 + c0) = w;
  } }
}

__device__ __forceinline__ void phase_qkv_post(int wsg) {
  ParamsK q = kparams();
  const int tid = opaque_tid(wsg), lane = tid & 63, wid = tid >> 6;
  const int wv = blockIdx.x * 8 + wid, nw = gridDim.x * 8;
  const bf16_t* QKVA = WSP(bf16_t, WS_QKVA); bf16_t* QAN = WSP(bf16_t, WS_QAN); bf16_t* KV = WSP(bf16_t, WS_KV);
  const f32x4 qn = *(const f32x4*)(q->q_norm + lane * 4);
  const float kn0 = q->kv_norm[lane * 2], kn1 = q->kv_norm[lane * 2 + 1];
  const float frev = rope_freq_rev(lane & 15);
  for (int row = wv; row < MALL; row += nw) {
    const bf16_t* rp = QKVA + (size_t)row * 512;
    const u32x2 qa = *(const u32x2*)(rp + lane * 4); const unsigned ka = *(const unsigned*)(rp + 256 + lane * 2); const float kr = bf_lo((unsigned)rp[384 + lane]);
    const float q0 = bf_lo(qa.x), q1 = bf_hi(qa.x), q2 = bf_lo(qa.y), q3 = bf_hi(qa.y), k0 = bf_lo(ka), k1 = bf_hi(ka);
    const float qss = wave_sum(q0 * q0 + q1 * q1 + q2 * q2 + q3 * q3), kss = wave_sum(k0 * k0 + k1 * k1);
    const float qr = rsqrtf(qss * (1.0f / 256.0f) + NORM_EPS), krs = rsqrtf(kss * (1.0f / 128.0f) + NORM_EPS);
    size_t kvrow; float kro = kr;
    if (row < MLAT) { const int b = row / SEQ, t = row % SEQ; kvrow = (size_t)b * SKV + CTX + t;
      u32x2 o; o.x = pk_bf16(q0 * qr * qn[0], q1 * qr * qn[1]); o.y = pk_bf16(q2 * qr * qn[2], q3 * qr * qn[3]);
      *(u32x2*)(QAN + (size_t)row * 256 + lane * 4) = o;
      const float pos = (float)(lane < 32 ? (t >> 6) : (t & 63)); float s, c; sincos_rev(pos * frev, s, c);
      const float xp = __shfl_xor(kr, 16);
      kro = (lane & 16) ? kr * c + xp * s : kr * c - xp * s;
    } else { const int r2 = row - MLAT; kvrow = (size_t)(r2 / CTX) * SKV + (r2 % CTX); }
    bf16_t* kp = KV + kvrow * DQK;
    *(unsigned*)(kp + lane * 2) = pk_bf16(k0 * krs * kn0, k1 * krs * kn1);
    kp[128 + lane] = (bf16_t)(pk_bf16(kro, 0.f) & 0xffffu);
  }
}

__device__ __forceinline__ void phase_attn(int wsg, unsigned char* shm) {
  ParamsK q = kparams();
  const bf16_t* Qb = WSP(bf16_t, WS_Q); const bf16_t* KV = WSP(bf16_t, WS_KV); bf16_t* Ob = WSP(bf16_t, WS_O);
  for (int u = blockIdx.x; u < NB * NH * (SEQ / 256); u += gridDim.x) {
    const int w = u & 255, r = u >> 8, xcd = w & 7, slot = w >> 3;
    const int b = xcd >> 1, idx = (xcd & 1) * 128 + r * 32 + slot, h = idx >> 5, qb = idx & 31;
    __syncthreads();
    att::attn_unit(wsg, Qb + ((size_t)(b * SEQ + qb * 256) * 1536 + h * DQK), KV + (size_t)b * SKV * DQK, Ob + ((size_t)(b * SEQ + qb * 256) * DM + h * 128), (LAS unsigned char*)shm);
  }
}

__device__ __forceinline__ void phase_conv(int wsg) {
  ParamsK q = kparams();
  const int tid = opaque_tid(wsg);
  const bf16_t* CV = WSP(bf16_t, WS_CV); const bf16_t* BG = WSP(bf16_t, WS_BG); bf16_t* Z = WSP(bf16_t, WS_Z);
  const float* cw = q->conv_w;
  const size_t nitem = (size_t)MLAT * DM / 8;
  for (size_t it = (size_t)blockIdx.x * 512 + tid; it < nitem; it += (size_t)gridDim.x * 512) {
    const int row = (int)(it >> 7), d0 = (int)(it & 127) * 8, t = row & (SEQ - 1);
    const u32x4 cur = *(const u32x4*)(CV + (size_t)row * DM + d0);
    u32x4 prv = (u32x4){0u, 0u, 0u, 0u}, nxt = (u32x4){0u, 0u, 0u, 0u};
    if (t > 0) prv = *(const u32x4*)(CV + (size_t)(row - 1) * DM + d0);
    if (t < SEQ - 1) nxt = *(const u32x4*)(CV + (size_t)(row + 1) * DM + d0);
    const u32x4 bg = *(const u32x4*)(BG + (size_t)row * DM + d0);
    const float* w0 = cw + d0; const float* w1 = cw + DM + d0; const float* w2 = cw + 2 * DM + d0;
    u32x4 o;
#pragma unroll
    for (int k = 0; k < 4; ++k) {
      const float ul = w0[2 * k] * bf_lo(prv[k]) + w1[2 * k] * bf_lo(cur[k]) + w2[2 * k] * bf_lo(nxt[k]);
      const float uh = w0[2 * k + 1] * bf_hi(prv[k]) + w1[2 * k + 1] * bf_hi(cur[k]) + w2[2 * k + 1] * bf_hi(nxt[k]);
      o[k] = pk_bf16(bf_lo(bg[k]) * ul, bf_hi(bg[k]) * uh); }
    *(u32x4*)(Z + (size_t)row * DM + d0) = o;
  }
}

#define GEMM_SETUP(M_, N_) ParamsK q = kparams(); pg8::StaticOrder S; S.init((M_), (N_), gridDim.x, blockIdx.x); LAS unsigned char* ldsl = (LAS unsigned char*)shm
__device__ __forceinline__ void phase_gemm_qkva(int wsg, unsigned char* shm) { GEMM_SETUP(MALL, 512);
  pg8::Gemm g{WSP(bf16_t, WS_H), WSP(bf16_t, WS_WQKVA), MALL, 512, DM}; pg8::EpiBf16 E{WSP(bf16_t, WS_QKVA), 512}; pg8::gemm_phase(wsg, ldsl, g, S, E); }
__device__ __forceinline__ void phase_gemm_uq(int wsg, unsigned char* shm) { GEMM_SETUP(MLAT, 1536);
  pg8::Gemm g{WSP(bf16_t, WS_QAN), WSP(bf16_t, WS_WUQ), MLAT, 1536, 256}; pg8::EpiQRope E{WSP(bf16_t, WS_Q)}; pg8::gemm_phase(wsg, ldsl, g, S, E); }
__device__ __forceinline__ void phase_gemm_mixout0(int wsg, unsigned char* shm) { GEMM_SETUP(MLAT, DM);
  pg8::Gemm g{WSP(bf16_t, WS_O), WSP(bf16_t, WS_WO), MLAT, DM, DM};
  pg8::EpiResid<true> E{q->x, WSP(bf16_t, WS_X16), WSP(float, WS_MOD) + 2048}; pg8::gemm_phase(wsg, ldsl, g, S, E); }
__device__ __forceinline__ void phase_gemm_mixout1(int wsg, unsigned char* shm) { GEMM_SETUP(MLAT, DM);
  pg8::Gemm g{WSP(bf16_t, WS_Z), WSP(bf16_t, WS_WOUT), MLAT, DM, DM};
  pg8::EpiResid<false> E{WSP(bf16_t, WS_X16), WSP(bf16_t, WS_X16), WSP(float, WS_MOD) + (size_t)5 * 6144 + 2048}; pg8::gemm_phase(wsg, ldsl, g, S, E); }
__device__ __forceinline__ void phase_gemm_convin(int wsg, unsigned char* shm) { GEMM_SETUP(MLAT, 3 * DM);
  pg8::Gemm g{WSP(bf16_t, WS_H), WSP(bf16_t, WS_WIN), MLAT, 3 * DM, DM}; pg8::EpiConvIn E{WSP(bf16_t, WS_CV), WSP(bf16_t, WS_BG)}; pg8::gemm_phase(wsg, ldsl, g, S, E); }
__device__ __forceinline__ void phase_gemm_gu(int wsg, unsigned char* shm, int layer) { GEMM_SETUP(MLAT, 2 * DFF);
  pg8::Gemm g{WSP(bf16_t, WS_H), WSP(bf16_t, layer ? WS_WGU1 : WS_WGU0), MLAT, 2 * DFF, DM}; pg8::EpiSwiglu E{WSP(bf16_t, WS_G), DFF}; pg8::gemm_phase(wsg, ldsl, g, S, E); }
__device__ __forceinline__ void phase_gemm_down(int wsg, unsigned char* shm, int layer) { GEMM_SETUP(MLAT, DM);
  pg8::Gemm g{WSP(bf16_t, WS_G), WSP(bf16_t, layer ? WS_WD1 : WS_WD0), MLAT, DM, DFF};
  pg8::EpiResid<false> E{WSP(bf16_t, WS_X16), WSP(bf16_t, WS_X16), WSP(float, WS_MOD) + (size_t)layer * 5 * 6144 + 5120}; pg8::gemm_phase(wsg, ldsl, g, S, E); }

#define XB_TMO      128
#define XB_XCNT(j)  (256  + 64 * (j))
#define XB_XSUB(j)  (1280 + 64 * (j))
#define XB_XGEN(j)  (2304 + 64 * (j))
#define XB_TOP      3328
#define XB_TOPGEN   3392
#define XB_SPIN_CAP (1u << 20)
constexpr int LDS_XB = LDS_BYTES - 16;
__device__ __forceinline__ unsigned xb_ld(unsigned* p)              { return __hip_atomic_load(p, __ATOMIC_RELAXED, __HIP_MEMORY_SCOPE_AGENT); }
__device__ __forceinline__ unsigned xb_add(unsigned* p, unsigned v) { return __hip_atomic_fetch_add(p, v, __ATOMIC_RELAXED, __HIP_MEMORY_SCOPE_AGENT); }
__device__ __forceinline__ unsigned xb_xcc_id() { return (unsigned)__builtin_amdgcn_s_getreg((3 << 11) | 20) & 0xFu; }
#define XB_SPIN(cond, bar) do { unsigned _sp = 0; while (cond) { __builtin_amdgcn_s_sleep(1); \
    if ((++_sp & 255u) == 0u) { if (xb_ld(&(bar)[XB_TMO])) break; if (_sp > XB_SPIN_CAP) { atomicAdd(&(bar)[XB_TMO], 1u); break; } } } } while (0)
__device__ __forceinline__ void xcd_barrier_complete(unsigned* bar, unsigned x, unsigned& nloc, unsigned& nx) {
  const unsigned G = gridDim.x;
  unsigned sum, cnt, mine, sp = 0u;
  for (;;) {
    sum = 0u; cnt = 0u; mine = 0u;
#pragma unroll
    for (unsigned j = 0; j < 16; ++j) { const unsigned c = xb_ld(&bar[XB_XCNT(j)]); sum += c; cnt += (c > 0u) ? 1u : 0u; mine = (j == x) ? c : mine; }
    if (sum == G) break;
    __builtin_amdgcn_s_sleep(1);
    if ((++sp & 255u) == 0u) { if (xb_ld(&bar[XB_TMO])) break; if (sp > XB_SPIN_CAP) { atomicAdd(&bar[XB_TMO], 1u); break; } }
  }
  nloc = mine > 0u ? mine : 1u; nx = cnt > 0u ? cnt : 1u;
}
__device__ __forceinline__ void grid_bar_post(int wsg, unsigned char* shm) {
  ParamsK q = kparams(); unsigned* bar = (unsigned*)q->ws; const unsigned x = xb_xcc_id();
  if (opaque_tid(wsg) == 0) { volatile LAS unsigned* st = (volatile LAS unsigned*)((LAS unsigned char*)shm + LDS_XB); st[0] = 0u; st[1] = 0u;
    (void)xb_add(&bar[XB_XCNT(x)], 1u); }
  __syncthreads();
}
__device__ __forceinline__ void grid_bar(int wsg, unsigned char* shm) {
  asm volatile("s_waitcnt vmcnt(0)" ::: "memory");
  __syncthreads();
  ParamsK q = kparams(); unsigned* bar = (unsigned*)q->ws; const unsigned x = xb_xcc_id();
  if (opaque_tid(wsg) == 0) {
    volatile LAS unsigned* st = (volatile LAS unsigned*)((LAS unsigned char*)shm + LDS_XB);
    __builtin_amdgcn_s_waitcnt(0);
    unsigned nloc = st[0], nx = st[1];
    if (nloc == 0u) { xcd_barrier_complete(bar, x, nloc, nx); st[0] = nloc; st[1] = nx; }
    const unsigned old = xb_add(&bar[XB_XSUB(x)], 1u);
    const unsigned gen = old / nloc;
    if (old + 1u == (gen + 1u) * nloc) {
      __builtin_amdgcn_fence(__ATOMIC_RELEASE, "agent");
      asm volatile("s_waitcnt vmcnt(0)" ::: "memory");
      const unsigned og = xb_add(&bar[XB_TOP], 1u);
      const unsigned tg = og / nx;
      if (og + 1u == (tg + 1u) * nx) xb_add(&bar[XB_TOPGEN], 1u);
      else XB_SPIN(xb_ld(&bar[XB_TOPGEN]) == tg, bar);
      __builtin_amdgcn_fence(__ATOMIC_ACQUIRE, "agent");
      xb_add(&bar[XB_XGEN(x)], 1u);
      asm volatile("s_waitcnt vmcnt(0)" ::: "memory");
    } else {
      XB_SPIN(xb_ld(&bar[XB_XGEN(x)]) == gen, bar);
      __builtin_amdgcn_fence(__ATOMIC_ACQUIRE, "agent");
      asm volatile("s_waitcnt vmcnt(0)" ::: "memory");
    }
  }
  __syncthreads();
}


__device__ __forceinline__ void phase_norm_mix0(int wsg) { ParamsK q = kparams();
  norm_rows<false, false>(wsg, q->x, q->ctx, nullptr, MALL, q->norm_mix, WSP(float, WS_MOD), 0, 1024, WSP(bf16_t, WS_H), nullptr); }
__device__ __forceinline__ void phase_norm_mix1(int wsg) { ParamsK q = kparams();
  norm_rows<false, true>(wsg, nullptr, nullptr, WSP(bf16_t, WS_X16), MLAT, q->norm_mix + DM, WSP(float, WS_MOD) + (size_t)5 * 6144, 0, 1024, WSP(bf16_t, WS_H), nullptr); }
template <int LAYER> __device__ __forceinline__ void phase_norm_ffn(int wsg) { ParamsK q = kparams();
  norm_rows<false, true>(wsg, nullptr, nullptr, WSP(bf16_t, WS_X16), MLAT, q->norm_ffn + LAYER * DM, WSP(float, WS_MOD) + (size_t)LAYER * 5 * 6144, 3072, 4096, WSP(bf16_t, WS_H), nullptr); }

__global__ void __launch_bounds__(512, 2) mk_fwd(Params p) {
  extern __shared__ __attribute__((aligned(16))) unsigned char shm[];
  cg::grid_group grid = cg::this_grid();
  const int wsg = __builtin_amdgcn_readfirstlane((int)(threadIdx.x >> 6));
  grid_bar_post(wsg, shm);
  phase_adaln(wsg, shm);
  grid_bar(wsg, shm);
  if (gridDim.x == 0x7fffffffu) grid.sync();
  phase_norm_mix0(wsg); phase_prologue(wsg, shm); grid_bar(wsg, shm);
  phase_gemm_qkva(wsg, shm); grid_bar(wsg, shm);
  phase_qkv_post(wsg); grid_bar(wsg, shm);
  phase_gemm_uq(wsg, shm); grid_bar(wsg, shm);
  phase_attn(wsg, shm); grid_bar(wsg, shm);
  phase_gemm_mixout0(wsg, shm); grid_bar(wsg, shm);
  phase_norm_ffn<0>(wsg); grid_bar(wsg, shm);
  phase_gemm_gu(wsg, shm, 0); grid_bar(wsg, shm);
  phase_gemm_down(wsg, shm, 0); grid_bar(wsg, shm);
  phase_norm_mix1(wsg); grid_bar(wsg, shm);
  phase_gemm_convin(wsg, shm); grid_bar(wsg, shm);
  phase_conv(wsg); grid_bar(wsg, shm);
  phase_gemm_mixout1(wsg, shm); grid_bar(wsg, shm);
  phase_norm_ffn<1>(wsg); grid_bar(wsg, shm);
  phase_gemm_gu(wsg, shm, 1); grid_bar(wsg, shm);
  phase_gemm_down(wsg, shm, 1); grid_bar(wsg, shm);
  { ParamsK q = kparams(); norm_rows<true, true>(wsg, nullptr, nullptr, WSP(bf16_t, WS_X16), MLAT, q->final_norm, nullptr, 0, 0, nullptr, q->out); }
}

extern "C" void kernel_launch(void* const* d_in, const int* in_sizes, int n_in, void* d_out, int out_size, void* d_ws, size_t ws_size, hipStream_t stream) {
  static int grid_blocks = 0;
  if (!grid_blocks) {
    if (ws_size < WS_END) { fprintf(stderr, "kernel_launch: ws too small %zu < %zu\n", ws_size, (size_t)WS_END); return; }
    if (hipFuncSetAttribute((const void*)mk_fwd, hipFuncAttributeMaxDynamicSharedMemorySize, LDS_BYTES) != hipSuccess) { fprintf(stderr, "kernel_launch: set LDS attr failed\n"); return; }
    int dev = 0, cus = 0, per_cu = 0;
    (void)hipGetDevice(&dev);
    (void)hipDeviceGetAttribute(&cus, hipDeviceAttributeMultiprocessorCount, dev);
    (void)hipOccupancyMaxActiveBlocksPerMultiprocessor(&per_cu, mk_fwd, 512, LDS_BYTES);
    if (per_cu < 1) { fprintf(stderr, "kernel_launch: occupancy 0\n"); return; }
    grid_blocks = cus;
  }
  Params p{};
  p.x = (const float*)d_in[0]; p.c = (const float*)d_in[1]; p.ctx = (const float*)d_in[2]; p.c_ctx = (const float*)d_in[3];
  p.ada_w = (const float*)d_in[4]; p.ada_b = (const float*)d_in[5]; p.norm_mix = (const float*)d_in[6]; p.norm_ffn = (const float*)d_in[7];
  p.w_dq = (const float*)d_in[8]; p.q_norm = (const float*)d_in[9]; p.w_uq = (const float*)d_in[10]; p.w_dkv = (const float*)d_in[11];
  p.kv_norm = (const float*)d_in[12]; p.w_ukv = (const float*)d_in[13]; p.w_o = (const float*)d_in[14];
  p.conv_w_in = (const float*)d_in[15]; p.conv_w = (const float*)d_in[16]; p.conv_w_out = (const float*)d_in[17];
  p.w_gate = (const float*)d_in[18]; p.w_up = (const float*)d_in[19]; p.w_down = (const float*)d_in[20]; p.final_norm = (const float*)d_in[21];
  p.out = (float*)d_out; p.ws = (unsigned char*)d_ws;
  void* args[] = {&p};
  (void)hipMemsetAsync(d_ws, 0, 16384, stream);
  hipError_t e = hipLaunchCooperativeKernel((void*)mk_fwd, dim3(grid_blocks), dim3(512), args, LDS_BYTES, stream);
  if (e != hipSuccess) fprintf(stderr, "cooperative launch failed: %s (grid %d)\n", hipGetErrorString(e), grid_blocks);
}
```

```cpp
#include <hip/hip_runtime.h>
#include <hip/hip_cooperative_groups.h>
#include <cstdio>
#include <cstdint>
namespace cg = cooperative_groups;

typedef unsigned short bf16_t;
typedef short bf16x8 __attribute__((ext_vector_type(8)));
typedef short s16x4 __attribute__((ext_vector_type(4)));
typedef float f32x4 __attribute__((ext_vector_type(4)));
typedef float f32x16 __attribute__((ext_vector_type(16)));
typedef unsigned u32x4 __attribute__((ext_vector_type(4)));
typedef unsigned u32x2 __attribute__((ext_vector_type(2)));
#define LAS __attribute__((address_space(3)))

constexpr int DM = 1024, NB = 4, SEQ = 8192, CTX = 256, NH = 8, DFF = 2816;
constexpr int MLAT = NB * SEQ;
constexpr int MCTX = NB * CTX;
constexpr int MALL = MLAT + MCTX;
constexpr int SKV = CTX + SEQ;
constexpr int DQK = 192;
constexpr float NORM_EPS = 1e-6f;

constexpr size_t MiB = 1u << 20;
constexpr size_t WS_MOD = 1 * MiB;
constexpr size_t WS_WQKVA = 2 * MiB;
constexpr size_t WS_WUQ = 3 * MiB;
constexpr size_t WS_WO = 4 * MiB;
constexpr size_t WS_WGU0 = 6 * MiB;
constexpr size_t WS_WD0 = 17 * MiB;
constexpr size_t WS_WIN = 23 * MiB;
constexpr size_t WS_WOUT = 29 * MiB;
constexpr size_t WS_WGU1 = 31 * MiB;
constexpr size_t WS_WD1 = 42 * MiB;
constexpr size_t WS_H = 48 * MiB;
constexpr size_t WS_BIG = 116 * MiB;
constexpr size_t WS_QKVA = WS_BIG;
constexpr size_t WS_QAN = WS_BIG + 33 * MiB;
constexpr size_t WS_KV = WS_BIG + 49 * MiB;
constexpr size_t WS_Q = WS_BIG + 64 * MiB;
constexpr size_t WS_O = WS_BIG + 160 * MiB;
constexpr size_t WS_G = WS_BIG;
constexpr size_t WS_CV = WS_BIG;
constexpr size_t WS_BG = WS_BIG + 64 * MiB;
constexpr size_t WS_Z = WS_BIG + 128 * MiB;
constexpr size_t WS_X16 = WS_BIG + 224 * MiB;
constexpr size_t WS_END = WS_BIG + 288 * MiB;
static_assert(WS_KV + (size_t)NB * SKV * DQK * 2 <= WS_Q && WS_QAN + (size_t)MLAT * 256 * 2 <= WS_KV && WS_QKVA + (size_t)MALL * 512 * 2 <= WS_QAN && WS_Q + (size_t)MLAT * 1536 * 2 <= WS_O && WS_O + (size_t)MLAT * DM * 2 <= WS_END && WS_G + (size_t)MLAT * DFF * 2 <= WS_END && WS_H + (size_t)MALL * DM * 2 <= WS_BIG, "ws map");

constexpr int LDS_BYTES = 163840;

typedef float f32x2_t __attribute__((ext_vector_type(2)));
typedef __bf16 bf16x2_t __attribute__((ext_vector_type(2)));
__device__ __forceinline__ unsigned pk_bf16(float lo, float hi) { const f32x2_t v = {lo, hi}; const bf16x2_t b = __builtin_convertvector(v, bf16x2_t); return __builtin_bit_cast(unsigned, b); }
__device__ __forceinline__ float bf_lo(unsigned u) { return __uint_as_float(u << 16); }
__device__ __forceinline__ float bf_hi(unsigned u) { return __uint_as_float(u & 0xffff0000u); }
__device__ __forceinline__ float wave_sum(float v) {
#pragma unroll
  for (int o = 32; o >= 1; o >>= 1) v += __shfl_xor(v, o);
  return v;
}
__device__ __forceinline__ int opaque_tid(int wsg) { int t; asm volatile("v_mbcnt_lo_u32_b32 %0, -1, 0\n\tv_mbcnt_hi_u32_b32 %0, -1, %0\n\tv_lshl_or_b32 %0, %1, 6, %0" : "=&v"(t) : "s"(wsg)); return t; }
__device__ __forceinline__ float silu_f(float x) { return x / (1.0f + __expf(-x)); }
__device__ __forceinline__ float rope_freq_rev(int i) { return __builtin_amdgcn_exp2f(-(float)i * (13.287712379549449f / 16.0f)) * 0.15915494309189535f; }
__device__ __forceinline__ void sincos_rev(float rev, float& s, float& c) { float f = rev - floorf(rev); s = __builtin_amdgcn_sinf(f); c = __builtin_amdgcn_cosf(f); }

namespace pg8 {
constexpr int BM = 256, BK = 64, HALF = 128, HTB = HALF * BK * 2, STAGE_BYTES = 8 * HTB, NXCD = 8, WGM = 8;
__device__ __forceinline__ int lds_byte(int r, int c) { const int st = (r >> 4) * 2 + (c >> 5), rr = r & 15, cc = c & 31, ob = rr * 64 + cc * 2; return st * 1024 + (ob ^ (((ob >> 9) & 1) << 5)); }
__device__ __forceinline__ void stage_rc(int b, int& R, int& C) { const int st = b / 1024, sb = b % 1024, swz = sb ^ (((sb >> 9) & 1) << 5); R = (st >> 1) * 16 + swz / 64; C = (st & 1) * 32 + (swz % 64) / 2; }
__device__ __forceinline__ int perm32(int rho) { const int n = rho >> 4, i = rho & 15; return 8 * (i >> 2) + 4 * n + (i & 3); }
struct Unit { int pm, pn; };
struct Gemm { const bf16_t* A; const bf16_t* Bt; int M, N, K; };
struct StaticOrder {
  int nM, nN, nwg, G, c;
  __device__ void init(int M, int N, int G_, int c_) { nM = M / BM; nN = N / BM; nwg = nM * nN; G = G_; c = c_; }
  __device__ bool next(int i, Unit& u) const {
    const long L = (long)i * G + c; if (L >= nwg) return false;
    int wgid = (int)L; { const int q = nwg / NXCD, r = nwg % NXCD, xcd = wgid % NXCD, off = wgid / NXCD; wgid = (xcd < r ? xcd * (q + 1) : r * (q + 1) + (xcd - r) * q) + off; }
    const int nig = WGM * nN, gid = wgid / nig, fm = gid * WGM, gsz = (nM - fm) < WGM ? (nM - fm) : WGM;
    u.pm = fm + ((wgid % nig) % gsz); u.pn = (wgid % nig) / gsz; return true;
  }
};

template <class Epi, bool ALIGN_EPI = true, bool SP2 = false>
__device__ __forceinline__ void gemm_phase(int wsg, LAS unsigned char* lds, const Gemm g, const StaticOrder& S, const Epi& E) {
  const int tid = opaque_tid(wsg), wid = __builtin_amdgcn_readfirstlane(tid >> 6), lane = tid & 63, wr = wid >> 2, wc = wid & 3, fr = lane & 15, fq = lane >> 4;
  const int K = g.K, nt = K / BK;
  unsigned voffA[2], voffB[2];
#pragma unroll
  for (int i = 0; i < 2; ++i) { int R, C; stage_rc(tid * 16 + i * 8192, R, C); const int Rb = Epi::PERM ? ((R & ~31) + perm32(R & 31)) : R;
    voffA[i] = (unsigned)(R * K + C) * 2u; voffB[i] = (unsigned)(Rb * K + C) * 2u; }
  const size_t kstep = (size_t)(BK * 2);
  const size_t hstep = (size_t)HALF * K * 2;
  const size_t tstep = 2 * hstep;
  const unsigned ldsw = (unsigned)wid * 1024u;
  const int aoff = lds_byte(wr * 64 + fr, fq * 8), boff = lds_byte(wc * 32 + fr, fq * 8);
#define PG8_SA(b, h) (((b) * 2 + (h)) * HTB)
#define PG8_SB(b, h) ((4 + (b) * 2 + (h)) * HTB)
#define PG8_STAGE(bufoff, gbase, voff) do { _Pragma("unroll") for (int _i = 0; _i < 2; ++_i) \
    __builtin_amdgcn_global_load_lds((const unsigned*)((const char*)(gbase) + (voff)[_i]), (LAS unsigned*)(lds + (bufoff) + ldsw + _i * 8192), 16, 0, 0); } while (0)
#define PG8_LDA(dst, b, h) do { _Pragma("unroll") for (int m = 0; m < 4; ++m) _Pragma("unroll") for (int k = 0; k < 2; ++k) dst[m][k] = *(const LAS bf16x8*)(lds + PG8_SA(b, h) + aoff + m * 2048 + k * 1024); } while (0)
#define PG8_LDB(dst, b, h) do { _Pragma("unroll") for (int n = 0; n < 2; ++n) _Pragma("unroll") for (int k = 0; k < 2; ++k) dst[n][k] = *(const LAS bf16x8*)(lds + PG8_SB(b, h) + boff + n * 2048 + k * 1024); } while (0)
#define PG8_MMA(ai, bj, At, Bt) do { __builtin_amdgcn_s_setprio(1); _Pragma("unroll") for (int m = 0; m < 4; ++m) _Pragma("unroll") for (int n = 0; n < 2; ++n) _Pragma("unroll") for (int k = 0; k < 2; ++k) \
    acc[ai][bj][m][n] = __builtin_amdgcn_mfma_f32_16x16x32_bf16(Bt[n][k], At[m][k], acc[ai][bj][m][n], 0, 0, 0); __builtin_amdgcn_s_setprio(0); } while (0)
#define PG8_WAIT_V(n) asm volatile("s_waitcnt vmcnt(" #n ")" ::: "memory")
#define PG8_WAIT_L(n) asm volatile("s_waitcnt lgkmcnt(" #n ")" ::: "memory")
#define PG8_BAR __builtin_amdgcn_s_barrier()
#define PG8_SCHED __builtin_amdgcn_sched_barrier(0)
  Unit cur, nxt; int ui = 0;
  if (!S.next(0, cur)) return;
  f32x4 acc[2][2][4][2];
#pragma unroll
  for (int a = 0; a < 2; ++a)
#pragma unroll
    for (int b = 0; b < 2; ++b)
#pragma unroll
      for (int m = 0; m < 4; ++m)
#pragma unroll
        for (int n = 0; n < 2; ++n) acc[a][b][m][n] = (f32x4){0.f, 0.f, 0.f, 0.f};
  bf16x8 At[4][2], B0[2][2], B1[2][2];
  const char* cA = (const char*)g.A + (size_t)cur.pm * tstep; const char* cB = (const char*)g.Bt + (size_t)cur.pn * tstep;
  if constexpr (SP2) {
    PG8_STAGE(PG8_SB(0, 0), cB, voffB); PG8_STAGE(PG8_SB(0, 1), cB + hstep, voffB); PG8_STAGE(PG8_SA(0, 0), cA, voffA); PG8_STAGE(PG8_SA(0, 1), cA + hstep, voffA);
    if (wr == 1) PG8_BAR;
    PG8_WAIT_V(2); PG8_BAR;
    PG8_STAGE(PG8_SB(1, 0), cB + kstep, voffB); PG8_STAGE(PG8_SA(1, 0), cA + kstep, voffA); PG8_STAGE(PG8_SB(1, 1), cB + hstep + kstep, voffB);
    PG8_WAIT_V(6); PG8_BAR;
  } else {
    PG8_STAGE(PG8_SB(0, 0), cB, voffB); PG8_STAGE(PG8_SA(0, 0), cA, voffA); PG8_STAGE(PG8_SB(0, 1), cB + hstep, voffB); PG8_STAGE(PG8_SA(0, 1), cA + hstep, voffA);
    if (wr == 1) PG8_BAR;
    PG8_WAIT_V(4); PG8_BAR;
    PG8_STAGE(PG8_SB(1, 0), cB + kstep, voffB); PG8_STAGE(PG8_SA(1, 0), cA + kstep, voffA); PG8_STAGE(PG8_SB(1, 1), cB + hstep + kstep, voffB);
    PG8_WAIT_V(6); PG8_BAR;
  }
  for (;;) {
    const bool has_next = S.next(ui + 1, nxt);
    const char* nA = has_next ? (const char*)g.A + (size_t)nxt.pm * tstep : cA; const char* nB = has_next ? (const char*)g.Bt + (size_t)nxt.pn * tstep : cB;
    for (int t = 0; t < nt; t += 2) {
      const bool last = (t == nt - 2);
      const char* a1 = cA + (size_t)(t + 1) * kstep;
      const char* a2 = last ? nA : cA + (size_t)(t + 2) * kstep; const char* b2 = last ? nB : cB + (size_t)(t + 2) * kstep;
      const char* a3 = a2 + kstep; const char* b3 = b2 + kstep;
      if constexpr (SP2) {
      PG8_LDB(B0, 0, 0); PG8_LDB(B1, 0, 1); PG8_SCHED; PG8_LDA(At, 0, 0); PG8_STAGE(PG8_SA(1, 1), a1 + hstep, voffA);
      PG8_WAIT_V(8); PG8_WAIT_L(0); PG8_BAR; PG8_MMA(0, 0, At, B0); PG8_MMA(0, 1, At, B1); PG8_BAR; PG8_SCHED;
      PG8_LDA(At, 0, 1); PG8_STAGE(PG8_SB(0, 0), b2, voffB); PG8_STAGE(PG8_SB(0, 1), b2 + hstep, voffB); PG8_STAGE(PG8_SA(0, 0), a2, voffA);
      PG8_WAIT_V(8); PG8_WAIT_L(0); PG8_BAR; PG8_MMA(1, 0, At, B0); PG8_MMA(1, 1, At, B1); PG8_BAR; PG8_SCHED;
      PG8_LDB(B0, 1, 0); PG8_LDB(B1, 1, 1); PG8_SCHED; PG8_LDA(At, 1, 0); PG8_STAGE(PG8_SA(0, 1), a2 + hstep, voffA);
      PG8_WAIT_V(8); PG8_WAIT_L(0); PG8_BAR; PG8_MMA(0, 0, At, B0); PG8_MMA(0, 1, At, B1); PG8_BAR; PG8_SCHED;
      PG8_LDA(At, 1, 1); PG8_STAGE(PG8_SB(1, 0), b3, voffB); PG8_STAGE(PG8_SB(1, 1), b3 + hstep, voffB); PG8_STAGE(PG8_SA(1, 0), a3, voffA);
      PG8_WAIT_V(8); PG8_WAIT_L(0); PG8_BAR; PG8_MMA(1, 0, At, B0); PG8_MMA(1, 1, At, B1); PG8_BAR; PG8_SCHED;
      } else {
      PG8_LDB(B0, 0, 0); PG8_SCHED; PG8_LDA(At, 0, 0); PG8_STAGE(PG8_SA(1, 1), a1 + hstep, voffA);
      PG8_WAIT_L(8); PG8_BAR; PG8_WAIT_L(0); PG8_MMA(0, 0, At, B0); PG8_BAR; PG8_SCHED;
      PG8_LDB(B1, 0, 1); PG8_STAGE(PG8_SB(0, 0), b2, voffB);
      PG8_BAR; PG8_WAIT_L(0); PG8_MMA(0, 1, At, B1); PG8_BAR;
      PG8_LDA(At, 0, 1); PG8_STAGE(PG8_SA(0, 0), a2, voffA);
      PG8_BAR; PG8_WAIT_L(0); PG8_MMA(1, 0, At, B0); PG8_BAR; PG8_SCHED;
      PG8_STAGE(PG8_SB(0, 1), b2 + hstep, voffB);
      PG8_WAIT_V(6); PG8_BAR; PG8_MMA(1, 1, At, B1); PG8_BAR;
      PG8_LDB(B0, 1, 0); PG8_SCHED; PG8_LDA(At, 1, 0); PG8_STAGE(PG8_SA(0, 1), a2 + hstep, voffA);
      PG8_WAIT_L(8); PG8_BAR; PG8_WAIT_L(0); PG8_MMA(0, 0, At, B0); PG8_BAR; PG8_SCHED;
      PG8_LDB(B1, 1, 1); PG8_STAGE(PG8_SB(1, 0), b3, voffB);
      PG8_BAR; PG8_WAIT_L(0); PG8_MMA(0, 1, At, B1); PG8_BAR;
      PG8_LDA(At, 1, 1); PG8_STAGE(PG8_SA(1, 0), a3, voffA);
      PG8_BAR; PG8_WAIT_L(0); PG8_MMA(1, 0, At, B0); PG8_BAR; PG8_SCHED;
      PG8_STAGE(PG8_SB(1, 1), b3 + hstep, voffB);
      PG8_WAIT_V(6); PG8_BAR; PG8_MMA(1, 1, At, B1); PG8_BAR;
      }
    }
    if constexpr (ALIGN_EPI) { if (wr == 0) PG8_BAR; }
    E(acc, cur, wr, wc, fr, fq);
    if (!has_next) break;
#pragma unroll
    for (int a = 0; a < 2; ++a)
#pragma unroll
      for (int b = 0; b < 2; ++b)
#pragma unroll
        for (int m = 0; m < 4; ++m)
#pragma unroll
          for (int n = 0; n < 2; ++n) acc[a][b][m][n] = (f32x4){0.f, 0.f, 0.f, 0.f};
    cur = nxt; cA = nA; cB = nB; ++ui;
    if constexpr (ALIGN_EPI) { if (wr == 1) PG8_BAR; }
  }
  PG8_WAIT_V(0);
  if constexpr (!ALIGN_EPI) { if (wr == 0) PG8_BAR; }
  PG8_BAR;
#undef PG8_SA
#undef PG8_SB
#undef PG8_STAGE
#undef PG8_LDA
#undef PG8_LDB
#undef PG8_MMA
#undef PG8_WAIT_V
#undef PG8_WAIT_L
#undef PG8_BAR
#undef PG8_SCHED
}

struct EpiBf16 {
  static constexpr bool PERM = true;
  bf16_t* O; int ldc;
  __device__ __forceinline__ void operator()(const f32x4 (&acc)[2][2][4][2], const Unit& u, int wr, int wc, int fr, int fq) const {
    const int row0 = u.pm * BM + wr * 64 + fr, col0 = u.pn * BM + wc * 32 + 8 * fq;
#pragma unroll
    for (int ai = 0; ai < 2; ++ai)
#pragma unroll
      for (int m = 0; m < 4; ++m) { bf16_t* rowp = O + (size_t)(row0 + ai * HALF + m * 16) * ldc + col0;
#pragma unroll
        for (int bj = 0; bj < 2; ++bj) { const f32x4 v0 = acc[ai][bj][m][0], v1 = acc[ai][bj][m][1];
          u32x4 w; w.x = pk_bf16(v0[0], v0[1]); w.y = pk_bf16(v0[2], v0[3]); w.z = pk_bf16(v1[0], v1[1]); w.w = pk_bf16(v1[2], v1[3]);
          *(u32x4*)(rowp + bj * HALF) = w; } }
  }
};
struct EpiQRope {
  static constexpr bool PERM = false;
  bf16_t* O;
  __device__ __forceinline__ void operator()(const f32x4 (&acc)[2][2][4][2], const Unit& u, int wr, int wc, int fr, int fq) const {
    const int row0 = u.pm * BM + wr * 64 + fr;
    float fr_rev[4];
#pragma unroll
    for (int j = 0; j < 4; ++j) fr_rev[j] = rope_freq_rev(4 * fq + j);
#pragma unroll
    for (int bj = 0; bj < 2; ++bj) {
      const int gq = u.pn * 8 + bj * 4 + wc;
      const int within = gq % 6;
      const int col0 = gq * 32 + 4 * fq;
#pragma unroll
      for (int ai = 0; ai < 2; ++ai)
#pragma unroll
        for (int m = 0; m < 4; ++m) {
          const int row = row0 + ai * HALF + m * 16;
          f32x4 v0 = acc[ai][bj][m][0], v1 = acc[ai][bj][m][1];
          if (within >= 4) {
            const int t = row & (SEQ - 1);
            const float pos = (float)(within == 4 ? (t >> 6) : (t & 63));
#pragma unroll
            for (int j = 0; j < 4; ++j) { float s, c; sincos_rev(pos * fr_rev[j], s, c);
              const float x1 = v0[j], x2 = v1[j]; v0[j] = x1 * c - x2 * s; v1[j] = x2 * c + x1 * s; }
          }
          bf16_t* rowp = O + (size_t)row * 1536 + col0;
          u32x2 w0, w1; w0.x = pk_bf16(v0[0], v0[1]); w0.y = pk_bf16(v0[2], v0[3]); w1.x = pk_bf16(v1[0], v1[1]); w1.y = pk_bf16(v1[2], v1[3]);
          *(u32x2*)(rowp) = w0; *(u32x2*)(rowp + 16) = w1;
        }
    }
  }
};
template <bool XIN_F32>
struct EpiResid {
  static constexpr bool PERM = true;
  const void* xin; bf16_t* xout; const float* gate;
  __device__ __forceinline__ void operator()(const f32x4 (&acc)[2][2][4][2], const Unit& u, int wr, int wc, int fr, int fq) const {
    const int row0 = u.pm * BM + wr * 64 + fr, col0 = u.pn * BM + wc * 32 + 8 * fq;
    const float* gp = gate + (size_t)((u.pm * BM) / SEQ) * 6144 + col0;
    f32x4 gv[2][2];
#pragma unroll
    for (int bj = 0; bj < 2; ++bj)
#pragma unroll
      for (int n = 0; n < 2; ++n) gv[bj][n] = *(const f32x4*)(gp + bj * HALF + n * 4);
    f32x4 xa[2][2], xb[2][2];
#define EPR_LOAD(X, g) do { const size_t off_ = (size_t)(row0 + ((g) >> 2) * HALF + ((g) & 3) * 16) * DM + col0; \
      _Pragma("unroll") for (int bj = 0; bj < 2; ++bj) { \
        if (XIN_F32) { X[bj][0] = *(const f32x4*)((const float*)xin + off_ + bj * HALF); X[bj][1] = *(const f32x4*)((const float*)xin + off_ + bj * HALF + 4); } \
        else { const u32x4 t_ = *(const u32x4*)((const bf16_t*)xin + off_ + bj * HALF); X[bj][0] = (f32x4){bf_lo(t_.x), bf_hi(t_.x), bf_lo(t_.y), bf_hi(t_.y)}; X[bj][1] = (f32x4){bf_lo(t_.z), bf_hi(t_.z), bf_lo(t_.w), bf_hi(t_.w)}; } } } while (0)
#define EPR_STORE(X, g) do { const size_t off_ = (size_t)(row0 + ((g) >> 2) * HALF + ((g) & 3) * 16) * DM + col0; \
      _Pragma("unroll") for (int bj = 0; bj < 2; ++bj) { const f32x4 v0_ = X[bj][0] + gv[bj][0] * acc[(g) >> 2][bj][(g) & 3][0], v1_ = X[bj][1] + gv[bj][1] * acc[(g) >> 2][bj][(g) & 3][1]; \
        u32x4 w_; w_.x = pk_bf16(v0_[0], v0_[1]); w_.y = pk_bf16(v0_[2], v0_[3]); w_.z = pk_bf16(v1_[0], v1_[1]); w_.w = pk_bf16(v1_[2], v1_[3]); *(u32x4*)(xout + off_ + bj * HALF) = w_; } } while (0)
    EPR_LOAD(xa, 0); EPR_LOAD(xb, 1);
    EPR_STORE(xa, 0); EPR_LOAD(xa, 2); EPR_STORE(xb, 1); EPR_LOAD(xb, 3);
    EPR_STORE(xa, 2); EPR_LOAD(xa, 4); EPR_STORE(xb, 3); EPR_LOAD(xb, 5);
    EPR_STORE(xa, 4); EPR_LOAD(xa, 6); EPR_STORE(xb, 5); EPR_LOAD(xb, 7);
    EPR_STORE(xa, 6); EPR_STORE(xb, 7);
#undef EPR_LOAD
#undef EPR_STORE
  }
};
struct EpiSwiglu {
  static constexpr bool PERM = true;
  bf16_t* O; int ldc;
  __device__ __forceinline__ void operator()(const f32x4 (&acc)[2][2][4][2], const Unit& u, int wr, int wc, int fr, int fq) const {
    const int row0 = u.pm * BM + wr * 64 + fr, col0 = u.pn * HALF + wc * 32 + 8 * fq;
#pragma unroll
    for (int ai = 0; ai < 2; ++ai)
#pragma unroll
      for (int m = 0; m < 4; ++m) { float r[8];
#pragma unroll
        for (int n = 0; n < 2; ++n) { const f32x4 g = acc[ai][0][m][n], up = acc[ai][1][m][n];
#pragma unroll
          for (int j = 0; j < 4; ++j) r[4 * n + j] = g[j] * __builtin_amdgcn_rcpf(1.0f + __builtin_amdgcn_exp2f(-g[j] * 1.4426950408889634f)) * up[j]; }
        u32x4 w; w.x = pk_bf16(r[0], r[1]); w.y = pk_bf16(r[2], r[3]); w.z = pk_bf16(r[4], r[5]); w.w = pk_bf16(r[6], r[7]);
        *(u32x4*)(O + (size_t)(row0 + ai * HALF + m * 16) * ldc + col0) = w; }
  }
};
struct EpiConvIn {
  static constexpr bool PERM = true;
  bf16_t* CV; bf16_t* BG;
  __device__ __forceinline__ void operator()(const f32x4 (&acc)[2][2][4][2], const Unit& u, int wr, int wc, int fr, int fq) const {
    const int row0 = u.pm * BM + wr * 64 + fr;
#pragma unroll
    for (int ai = 0; ai < 2; ++ai)
#pragma unroll
      for (int m = 0; m < 4; ++m) { const size_t row = (size_t)(row0 + ai * HALF + m * 16);
        if (u.pn < 8) { const f32x4 r0 = acc[ai][0][m][0] * acc[ai][1][m][0], r1 = acc[ai][0][m][1] * acc[ai][1][m][1];
          u32x4 w; w.x = pk_bf16(r0[0], r0[1]); w.y = pk_bf16(r0[2], r0[3]); w.z = pk_bf16(r1[0], r1[1]); w.w = pk_bf16(r1[2], r1[3]);
          *(u32x4*)(CV + row * DM + u.pn * HALF + wc * 32 + 8 * fq) = w;
        } else {
#pragma unroll
          for (int bj = 0; bj < 2; ++bj) { const f32x4 a = acc[ai][bj][m][0], b = acc[ai][bj][m][1];
            u32x4 w; w.x = pk_bf16(a[0], a[1]); w.y = pk_bf16(a[2], a[3]); w.z = pk_bf16(b[0], b[1]); w.w = pk_bf16(b[2], b[3]);
            *(u32x4*)(BG + row * DM + (u.pn - 8) * BM + bj * HALF + wc * 32 + 8 * fq) = w; } } }
  }
};
}

namespace att {
constexpr int NW = 8, QBLK = 32, KVBLK = 64;
constexpr int LDQ = 1536, LDK = DQK, LDO = 1024;
constexpr float SCALE = 0.07216878364870322f;
constexpr float THR = 8.f;
constexpr int SHM_V = KVBLK * 128 * 2, SHM_K = KVBLK * DQK * 2;
constexpr int SHM_ATTN = 2 * SHM_V + 2 * SHM_K + NW * 64 * 4;
#define KSWZ(row, colB) ((row) * 384 + ((colB) ^ ((((row) >> 1) & 7) << 4)))
#define SBAR() __builtin_amdgcn_sched_barrier(0)
__device__ __forceinline__ int crow(int r, int hi) { return (r & 3) + 8 * (r >> 2) + 4 * hi; }
__device__ __forceinline__ unsigned cvtpk(float lo, float hi) { return pk_bf16(lo, hi); }

__device__ __forceinline__ void partialSM(f32x16& p0, f32x16& p1, float& m_reg, float& mn, float& alpha) {
  constexpr float C = SCALE * 1.4426950408889634f;
  float pmax = p0[0];
#pragma unroll
  for (int r = 1; r < 16; ++r) pmax = fmaxf(pmax, p0[r]);
#pragma unroll
  for (int r = 0; r < 16; ++r) pmax = fmaxf(pmax, p1[r]);
  { auto rr = __builtin_amdgcn_permlane32_swap(__float_as_uint(pmax), __float_as_uint(pmax), false, false);
    pmax = fmaxf(__uint_as_float(rr[0]), __uint_as_float(rr[1])); }
  if (__builtin_expect(__all(pmax - m_reg <= THR / SCALE), 1)) { mn = m_reg; alpha = 1.f; }
  else { mn = fmaxf(m_reg, pmax); alpha = __builtin_amdgcn_exp2f((m_reg - mn) * C); m_reg = mn; }
  float mnC = -mn * C;
#pragma unroll
  for (int r = 0; r < 16; ++r) p0[r] = fmaf(p0[r], C, mnC);
#pragma unroll
  for (int r = 0; r < 16; ++r) p1[r] = fmaf(p1[r], C, mnC);
#pragma unroll
  for (int r = 0; r < 16; ++r) p0[r] = __builtin_amdgcn_exp2f(p0[r]);
}
__device__ __forceinline__ void finishSM(f32x16& p0, f32x16& p1, float alpha, float& l_reg, bf16x8& pa0, bf16x8& pa1, bf16x8& pa2, bf16x8& pa3) {
#pragma unroll
  for (int r = 0; r < 16; ++r) p1[r] = __builtin_amdgcn_exp2f(p1[r]);
  float ps = 0;
#pragma unroll
  for (int r = 0; r < 16; ++r) ps += p0[r];
#pragma unroll
  for (int r = 0; r < 16; ++r) ps += p1[r];
  { auto rr = __builtin_amdgcn_permlane32_swap(__float_as_uint(ps), __float_as_uint(ps), false, false);
    ps = __uint_as_float(rr[0]) + __uint_as_float(rr[1]); }
  l_reg = l_reg * alpha + ps;
#define PK4(P, BASE, OUT) do { unsigned a0 = cvtpk(P[BASE + 0], P[BASE + 1]), a1 = cvtpk(P[BASE + 2], P[BASE + 3]);   \
    unsigned b0 = cvtpk(P[BASE + 4], P[BASE + 5]), b1 = cvtpk(P[BASE + 6], P[BASE + 7]);                              \
    auto r0 = __builtin_amdgcn_permlane32_swap(a0, b0, false, false); auto r1 = __builtin_amdgcn_permlane32_swap(a1, b1, false, false); \
    u32x4 w = {r0[0], r1[0], r0[1], r1[1]}; OUT = *reinterpret_cast<bf16x8*>(&w); } while (0)
  PK4(p0, 0, pa0); PK4(p0, 8, pa1); PK4(p1, 0, pa2); PK4(p1, 8, pa3);
#undef PK4
}
__device__ __forceinline__ void qkt(f32x16& p0, f32x16& p1, const char* Ks, const bf16x8* qr, int r32, int hi) {
  p0 = f32x16{}; p1 = f32x16{};
#pragma unroll
  for (int d0 = 0; d0 < 12; ++d0) { int cb = (d0 * 16 + hi * 8) * 2;
    bf16x8 b0 = *reinterpret_cast<const bf16x8*>(Ks + KSWZ(r32, cb));
    bf16x8 b1 = *reinterpret_cast<const bf16x8*>(Ks + KSWZ(32 + r32, cb));
    p0 = __builtin_amdgcn_mfma_f32_32x32x16_bf16(b0, qr[d0], p0, 0, 0, 0);
    p1 = __builtin_amdgcn_mfma_f32_32x32x16_bf16(b1, qr[d0], p1, 0, 0, 0);
    if ((d0 & 3) == 3 && d0 != 11) SBAR(); }
}
__device__ __forceinline__ int v_st(int k, int c) { const int kk = (k & ~0xC) | ((k & 4) << 1) | ((k & 8) >> 1); return ((kk >> 3) * 4 + (c >> 5)) * 512 + ((kk & 7) * 32 + (c & 31)) * 2; }
__device__ __forceinline__ int v_rd_base(int lane) { return ((lane & 3) << 3) | (((lane >> 2) & 3) << 6) | (((lane >> 4) & 1) << 5) | (((lane >> 5) & 1) << 8); }
constexpr int v_rd_off(int d0, int ks, int half) { return d0 * 512 + ks * 4096 + half * 2048; }
template <int OFF> __device__ __forceinline__ s16x4 tr_read(int vb) {
  s16x4 r; asm volatile("ds_read_b64_tr_b16 %0, %1 offset:%2" : "=&v"(r) : "v"(vb), "i"(OFF) : "memory"); return r;
}
template <int D0> __device__ __forceinline__ void pv_one(f32x16& od, int vb, bf16x8 pa0, bf16x8 pa1, bf16x8 pa2, bf16x8 pa3) {
  const s16x4 l0 = tr_read<v_rd_off(D0, 0, 0)>(vb), h0 = tr_read<v_rd_off(D0, 0, 1)>(vb), l1 = tr_read<v_rd_off(D0, 1, 0)>(vb), h1 = tr_read<v_rd_off(D0, 1, 1)>(vb);
  const s16x4 l2 = tr_read<v_rd_off(D0, 2, 0)>(vb), h2 = tr_read<v_rd_off(D0, 2, 1)>(vb), l3 = tr_read<v_rd_off(D0, 3, 0)>(vb), h3 = tr_read<v_rd_off(D0, 3, 1)>(vb);
  asm volatile("s_waitcnt lgkmcnt(0)" ::: "memory"); SBAR();
#define PK(L, H) (bf16x8){L[0], L[1], L[2], L[3], H[0], H[1], H[2], H[3]}
  od = __builtin_amdgcn_mfma_f32_32x32x16_bf16(pa0, PK(l0, h0), od, 0, 0, 0);
  od = __builtin_amdgcn_mfma_f32_32x32x16_bf16(pa1, PK(l1, h1), od, 0, 0, 0);
  od = __builtin_amdgcn_mfma_f32_32x32x16_bf16(pa2, PK(l2, h2), od, 0, 0, 0);
  od = __builtin_amdgcn_mfma_f32_32x32x16_bf16(pa3, PK(l3, h3), od, 0, 0, 0);
#undef PK
}
__device__ __forceinline__ void pv_d0(f32x16* o, int vb, bf16x8 pa0, bf16x8 pa1, bf16x8 pa2, bf16x8 pa3) {
  pv_one<0>(o[0], vb, pa0, pa1, pa2, pa3); pv_one<1>(o[1], vb, pa0, pa1, pa2, pa3); pv_one<2>(o[2], vb, pa0, pa1, pa2, pa3); pv_one<3>(o[3], vb, pa0, pa1, pa2, pa3);
}

constexpr int SLOT = SHM_K + SHM_V;
constexpr int NTILE = SKV / KVBLK;
static_assert(NTILE % 6 == 0, "tile loop is unrolled by 6");
constexpr int ATT_WS = 3 * SLOT;
__device__ __forceinline__ void attn_unit(int wsg, const bf16_t* __restrict__ Qb, const bf16_t* __restrict__ Kh, bf16_t* __restrict__ Ob, LAS unsigned char* ldsl) {
  const int tid = opaque_tid(wsg), wid = __builtin_amdgcn_readfirstlane(tid >> 6), lane = tid & 63, r32 = lane & 31, hi = lane >> 5;
  LAS float* ws = (LAS float*)(ldsl + ATT_WS) + wid * 64; LAS float* li_l = ws; LAS float* al_l = ws + 32;
  float m_reg = -1e30f, l_reg = 0; f32x16 o[4] = {}; bf16x8 qr[8];
  const bf16_t* Qw = Qb + (long)(wid * QBLK + r32) * LDQ + hi * 8;
#pragma unroll
  for (int d0 = 0; d0 < 8; ++d0) qr[d0] = *reinterpret_cast<const bf16x8*>(Qw + d0 * 16);
  LAS bf16x8* qlds = (LAS bf16x8*)(ldsl + ATT_WS + 2048 + wid * 4096) + lane;
#pragma unroll
  for (int i = 0; i < 4; ++i) qlds[i * 64] = *reinterpret_cast<const bf16x8*>(Qw + (8 + i) * 16);
  unsigned soff[5];
#pragma unroll
  for (int i = 0; i < 5; ++i) { const int ob = (wid * 5 + i) * 1024 + lane * 16;
    if (ob < SHM_K) { const int row = ob / 384, cph = ob % 384; soff[i] = (unsigned)(row * 384 + (cph ^ (((row >> 1) & 7) << 4))); }
    else { const int o2 = ob - SHM_K, st = o2 >> 9, wi = o2 & 511, kk = (st >> 2) * 8 + (wi >> 6), cc = (wi & 63) >> 1, cg = st & 3;
      const int k = (kk & ~0xC) | ((kk & 4) << 1) | ((kk & 8) >> 1); soff[i] = (unsigned)(k * 384 + (cg * 32 + cc) * 2); } }
  const int tsw = (hi * 16) ^ (((r32 >> 1) & 7) << 4);
  int kbs[4];
#pragma unroll
  for (int m = 0; m < 4; ++m) kbs[m] = r32 * 384 + ((m * 32) ^ tsw);
  const int vb0 = (int)(uintptr_t)(ldsl + SHM_K) + v_rd_base(lane);
#define ISSUE(SI, TI) do { const char* gb_ = (const char*)Kh + (size_t)(TI) * (KVBLK * 384); asm volatile("" : "+s"(gb_)); \
    _Pragma("unroll") for (int i_ = 0; i_ < 5; ++i_) __builtin_amdgcn_global_load_lds((const unsigned*)(gb_ + soff[i_]), (LAS unsigned*)(ldsl + (SI) * SLOT + (wid * 5 + i_) * 1024), 16, 0, 0); } while (0)
#define WAITBAR() asm volatile("s_waitcnt vmcnt(0) lgkmcnt(0)\n\ts_barrier" ::: "memory")
#define RESC(a) do { if (__any((a) < 1.f)) { if (hi == 0) al_l[r32] = (a); asm volatile("s_waitcnt lgkmcnt(0)" ::: "memory"); \
    _Pragma("unroll") for (int d = 0; d < 4; ++d) _Pragma("unroll") for (int r = 0; r < 16; ++r) o[d][r] *= al_l[crow(r, hi)]; } } while (0)
#define KLD(d0, SK, H) (*(const LAS bf16x8*)(ldsl + kbs[(d0) & 3] + ((SK) * SLOT + ((d0) >> 2) * 128 + (H) * (32 * 384))))
#define QKT(P0, P1, SK) do { P0 = f32x16{}; P1 = f32x16{}; \
    _Pragma("unroll") for (int d0 = 0; d0 < 12; ++d0) { \
      const bf16x8 b0_ = KLD(d0, SK, 0); const bf16x8 b1_ = KLD(d0, SK, 1); \
      bf16x8 qf_; if (d0 < 8) qf_ = qr[d0 < 8 ? d0 : 0]; else qf_ = qlds[(d0 - 8) * 64]; \
      P0 = __builtin_amdgcn_mfma_f32_32x32x16_bf16(b0_, qf_, P0, 0, 0, 0); \
      P1 = __builtin_amdgcn_mfma_f32_32x32x16_bf16(b1_, qf_, P1, 0, 0, 0); } } while (0)
#define QKT_SCHED() do { __builtin_amdgcn_sched_group_barrier(0x100, 2, 0); \
    _Pragma("unroll") for (int d0 = 0; d0 < 12; ++d0) { \
      __builtin_amdgcn_sched_group_barrier(0x008, 1, 0); __builtin_amdgcn_sched_group_barrier(0x400, 1, 0); __builtin_amdgcn_sched_group_barrier(0x002, 4, 0); \
      if (d0 < 7) __builtin_amdgcn_sched_group_barrier(0x100, 2, 0); else if (d0 < 11) __builtin_amdgcn_sched_group_barrier(0x100, 3, 0); \
      __builtin_amdgcn_sched_group_barrier(0x008, 1, 0); __builtin_amdgcn_sched_group_barrier(0x400, 1, 0); __builtin_amdgcn_sched_group_barrier(0x002, 4, 0); } } while (0)
#define PSM_A(P0, P1) do { pmax_ = P0[0]; _Pragma("unroll") for (int r = 1; r < 16; ++r) pmax_ = fmaxf(pmax_, P0[r]); _Pragma("unroll") for (int r = 0; r < 16; ++r) pmax_ = fmaxf(pmax_, P1[r]); } while (0)
#define PSM_B(P0, P1, MN, AL) do { constexpr float C_ = SCALE * 1.4426950408889634f; \
    { auto rr_ = __builtin_amdgcn_permlane32_swap(__float_as_uint(pmax_), __float_as_uint(pmax_), false, false); pmax_ = fmaxf(__uint_as_float(rr_[0]), __uint_as_float(rr_[1])); } \
    const bool keep_ = __all(pmax_ - m_reg <= THR / SCALE); const float mc_ = fmaxf(m_reg, pmax_); const float a2_ = __builtin_amdgcn_exp2f((m_reg - mc_) * C_); \
    MN = keep_ ? m_reg : mc_; AL = keep_ ? 1.f : a2_; m_reg = MN; mnC_ = -MN * C_; \
    _Pragma("unroll") for (int r = 0; r < 16; ++r) P0[r] = fmaf(P0[r], C_, mnC_); } while (0)
#define PSM_C(P0, P1) do { constexpr float C_ = SCALE * 1.4426950408889634f; \
    _Pragma("unroll") for (int r = 0; r < 16; ++r) P1[r] = fmaf(P1[r], C_, mnC_); \
    _Pragma("unroll") for (int r = 0; r < 4; ++r) P0[r] = __builtin_amdgcn_exp2f(P0[r]); } while (0)
#define PSM_D(P0) do { _Pragma("unroll") for (int r = 4; r < 16; ++r) P0[r] = __builtin_amdgcn_exp2f(P0[r]); } while (0)
#define HALF(PX0, PX1, MNX, ALX, PY0, PY1, ALY, SK, SV, SI, TI) do { \
    WAITBAR(); \
    if ((TI) < NTILE) ISSUE(SI, TI); \
    SBAR(); QKT(PX0, PX1, SK); \
    finishSM(PY0, PY1, ALY, l_reg, pa0, pa1, pa2, pa3); QKT_SCHED(); SBAR(); \
    { float pmax_, mnC_; const int vb_ = vb0 + (SV) * SLOT; \
      pv_one<0>(o[0], vb_, pa0, pa1, pa2, pa3); PSM_A(PX0, PX1); \
      pv_one<1>(o[1], vb_, pa0, pa1, pa2, pa3); PSM_B(PX0, PX1, MNX, ALX); \
      pv_one<2>(o[2], vb_, pa0, pa1, pa2, pa3); PSM_C(PX0, PX1); \
      pv_one<3>(o[3], vb_, pa0, pa1, pa2, pa3); PSM_D(PX0); asm volatile("" : "+v"(PX0), "+v"(PX1)); } \
    RESC(ALX); } while (0)
  f32x16 pA0, pA1, pB0, pB1; float mnA, mnB, alA, alB; bf16x8 pa0, pa1, pa2, pa3;
  ISSUE(0, 0); WAITBAR(); ISSUE(1, 1);
  QKT(pA0, pA1, 0); partialSM(pA0, pA1, m_reg, mnA, alA);
  for (int j = 1; j + 5 < NTILE; j += 6) {
    HALF(pB0, pB1, mnB, alB, pA0, pA1, alA, 1, 0, 2, j + 1);
    HALF(pA0, pA1, mnA, alA, pB0, pB1, alB, 2, 1, 0, j + 2);
    HALF(pB0, pB1, mnB, alB, pA0, pA1, alA, 0, 2, 1, j + 3);
    HALF(pA0, pA1, mnA, alA, pB0, pB1, alB, 1, 0, 2, j + 4);
    HALF(pB0, pB1, mnB, alB, pA0, pA1, alA, 2, 1, 0, j + 5);
    HALF(pA0, pA1, mnA, alA, pB0, pB1, alB, 0, 2, 1, j + 6);
  }
  HALF(pB0, pB1, mnB, alB, pA0, pA1, alA, 1, 0, 2, NTILE - 4);
  HALF(pA0, pA1, mnA, alA, pB0, pB1, alB, 2, 1, 0, NTILE - 3);
  HALF(pB0, pB1, mnB, alB, pA0, pA1, alA, 0, 2, 1, NTILE - 2);
  HALF(pA0, pA1, mnA, alA, pB0, pB1, alB, 1, 0, 2, NTILE - 1);
  HALF(pB0, pB1, mnB, alB, pA0, pA1, alA, 2, 1, 0, NTILE);
  finishSM(pB0, pB1, alB, l_reg, pa0, pa1, pa2, pa3); SBAR();
  pv_d0(o, vb0 + 2 * SLOT, pa0, pa1, pa2, pa3);
  if (hi == 0) li_l[r32] = l_reg; asm volatile("s_waitcnt lgkmcnt(0)" ::: "memory");
  bf16_t* Ow = Ob + (long)(wid * QBLK) * LDO;
#pragma unroll
  for (int r = 0; r < 16; ++r) { const int orow = crow(r, hi); const float rli = __builtin_amdgcn_rcpf(li_l[orow]);
#pragma unroll
    for (int d0 = 0; d0 < 4; ++d0) Ow[(long)orow * LDO + d0 * 32 + r32] = (bf16_t)(pk_bf16(o[d0][r] * rli, 0.f) & 0xffffu); }
#undef ISSUE
#undef WAITBAR
#undef RESC
#undef QKT
#undef PSM_A
#undef PSM_B
#undef PSM_C
#undef PSM_D
#undef QKT_SCHED
#undef KLD
#undef HALF
}
}

struct Params {
  const float* x; const float* c; const float* ctx; const float* c_ctx; const float* ada_w; const float* ada_b; const float* norm_mix; const float* norm_ffn;
  const float* w_dq; const float* q_norm; const float* w_uq; const float* w_dkv; const float* kv_norm; const float* w_ukv; const float* w_o;
  const float* conv_w_in; const float* conv_w; const float* conv_w_out; const float* w_gate; const float* w_up; const float* w_down; const float* final_norm;
  float* out; unsigned char* ws;
};

template <bool FINAL, bool SRC16>
__device__ __forceinline__ void norm_rows(int wsg, const float* src_lat, const float* src_ctx, const bf16_t* src16, int nrows, const float* w, const float* mod, int sh_off, int sc_off, bf16_t* H, float* outf) {
  const int tid_ = opaque_tid(wsg); const int lane = tid_ & 63, wv = blockIdx.x * 8 + (tid_ >> 6), nw = gridDim.x * 8;
  f32x4 wv4[4];
#pragma unroll
  for (int i = 0; i < 2; ++i) { wv4[2 * i] = *(const f32x4*)(w + i * 512 + lane * 8); wv4[2 * i + 1] = *(const f32x4*)(w + i * 512 + lane * 8 + 4); }
  for (int row = wv; row < nrows; row += nw) {
    f32x4 v[4]; float ss = 0.f;
    if (SRC16) { const bf16_t* xp = src16 + (size_t)row * DM;
#pragma unroll
      for (int i = 0; i < 2; ++i) { const u32x4 t = *(const u32x4*)(xp + i * 512 + lane * 8); v[2 * i] = (f32x4){bf_lo(t.x), bf_hi(t.x), bf_lo(t.y), bf_hi(t.y)}; v[2 * i + 1] = (f32x4){bf_lo(t.z), bf_hi(t.z), bf_lo(t.w), bf_hi(t.w)}; }
    } else { const float* xp = row < MLAT ? src_lat + (size_t)row * DM : src_ctx + (size_t)(row - MLAT) * DM;
#pragma unroll
      for (int i = 0; i < 2; ++i) { v[2 * i] = *(const f32x4*)(xp + i * 512 + lane * 8); v[2 * i + 1] = *(const f32x4*)(xp + i * 512 + lane * 8 + 4); } }
#pragma unroll
    for (int i = 0; i < 4; ++i) ss += v[i][0] * v[i][0] + v[i][1] * v[i][1] + v[i][2] * v[i][2] + v[i][3] * v[i][3];
    ss = wave_sum(ss);
    const float rstd = rsqrtf(ss * (1.0f / DM) + NORM_EPS);
    if (FINAL) {
#pragma unroll
      for (int i = 0; i < 2; ++i) { *(f32x4*)(outf + (size_t)row * DM + i * 512 + lane * 8) = v[2 * i] * rstd * wv4[2 * i]; *(f32x4*)(outf + (size_t)row * DM + i * 512 + lane * 8 + 4) = v[2 * i + 1] * rstd * wv4[2 * i + 1]; }
    } else {
      const int mr = row < MLAT ? row / SEQ : 4;
      const float* mp = mod + (size_t)mr * 6144;
#pragma unroll
      for (int i = 0; i < 2; ++i) { const int c = i * 512 + lane * 8;
        const f32x4 sh0 = *(const f32x4*)(mp + sh_off + c), sh1 = *(const f32x4*)(mp + sh_off + c + 4), sc0 = *(const f32x4*)(mp + sc_off + c), sc1 = *(const f32x4*)(mp + sc_off + c + 4);
        const f32x4 h0 = v[2 * i] * rstd * wv4[2 * i] * (1.0f + sc0) + sh0, h1 = v[2 * i + 1] * rstd * wv4[2 * i + 1] * (1.0f + sc1) + sh1;
        u32x4 o; o.x = pk_bf16(h0[0], h0[1]); o.y = pk_bf16(h0[2], h0[3]); o.z = pk_bf16(h1[0], h1[1]); o.w = pk_bf16(h1[2], h1[3]);
        *(u32x4*)(H + (size_t)row * DM + c) = o; }
    }
  }
}

typedef const __attribute__((address_space(4))) Params* ParamsK;
__device__ __forceinline__ ParamsK kparams() { auto kp = __builtin_amdgcn_kernarg_segment_ptr(); asm volatile("" : "+s"(kp)); return (ParamsK)kp; }
#define WSP(T, OFF) ((T*)(q->ws + (OFF)))

__device__ __forceinline__ void phase_adaln(int wsg, unsigned char* shm) {
  ParamsK q = kparams();
  const int tid = opaque_tid(wsg), lane = tid & 63, wid = tid >> 6;
  const int G = gridDim.x, bid = blockIdx.x;
  float* lds_f = (float*)shm;
  float* mod = WSP(float, WS_MOD);
  for (int it = bid; it < 2 * 96; it += G) {
    const int layer = it / 96, n0 = (it % 96) * 64;
    float* sv = lds_f;
    float* part = lds_f + 5 * 1024;
    const float* cp = q->c; const float* ccp = q->c_ctx;
    for (int e = tid; e < 5 * 1024; e += 512) { const int r = e >> 10, k = e & 1023; const float cv = r < 4 ? cp[r * DM + k] : ccp[k]; sv[e] = silu_f(cv); }
    __syncthreads();
    float a0 = 0.f, a1 = 0.f, a2 = 0.f, a3 = 0.f, a4 = 0.f;
    const float* wp = q->ada_w + (size_t)layer * DM * 6144 + n0 + lane;
    for (int k = wid * 128; k < wid * 128 + 128; ++k) { const float wv = wp[(size_t)k * 6144];
      a0 += sv[k] * wv; a1 += sv[1024 + k] * wv; a2 += sv[2048 + k] * wv; a3 += sv[3072 + k] * wv; a4 += sv[4096 + k] * wv; }
    part[(wid * 5 + 0) * 64 + lane] = a0; part[(wid * 5 + 1) * 64 + lane] = a1; part[(wid * 5 + 2) * 64 + lane] = a2; part[(wid * 5 + 3) * 64 + lane] = a3; part[(wid * 5 + 4) * 64 + lane] = a4;
    __syncthreads();
    if (tid < 320) { const int r = tid >> 6, l = tid & 63; float s = 0.f;
#pragma unroll
      for (int w8 = 0; w8 < 8; ++w8) s += part[(w8 * 5 + r) * 64 + l];
      mod[((size_t)layer * 5 + r) * 6144 + n0 + l] = s + q->ada_b[layer * 6144 + n0 + l]; }
    __syncthreads();
  }
}
__device__ __forceinline__ void phase_prologue(int wsg, unsigned char* shm) {
  ParamsK q = kparams();
  const int tid = opaque_tid(wsg);
  const int G = gridDim.x, bid = blockIdx.x;
  float* lds_f = (float*)shm;
  {
    constexpr int T_QKVA = 8 * 16, T_GU = 88 * 16, T_D = 16 * 44, T_IN = 48 * 16, T_OUT = 16 * 16;
    constexpr int T_TOTAL = T_QKVA + 2 * T_GU + 2 * T_D + T_IN + T_OUT;
    const int t = tid, chunk = (t & 15) >> 2, cc = (t & 3) * 4;
    struct TItem { const float* sp; int ld; bf16_t* dst; int Kdst; int n0, k0; };
    auto decode = [&](int it) -> TItem { TItem r; int i = it;
      if (i < T_QKVA) { const int tn = i / 16, tk = i % 16, n16 = tn * 64 + 16 * chunk; r.n0 = tn * 64; r.k0 = tk * 64; r.dst = WSP(bf16_t, WS_WQKVA); r.Kdst = DM;
        if (tn < 4) { r.sp = q->w_dq + n16; r.ld = 256; } else { r.sp = n16 < 448 ? q->w_dkv + (n16 - 256) : (const float*)nullptr; r.ld = 192; } return r; }
      i -= T_QKVA;
      for (int layer = 0; layer < 2; ++layer) {
        if (i < T_GU) { const int tn = i / 16, tk = i % 16, n16 = tn * 64 + 16 * chunk; r.n0 = tn * 64; r.k0 = tk * 64; r.dst = WSP(bf16_t, layer ? WS_WGU1 : WS_WGU0); r.Kdst = DM; r.ld = DFF;
          r.sp = ((n16 & 128) ? q->w_up : q->w_gate) + (size_t)layer * DM * DFF + (n16 >> 8) * 128 + (n16 & 127); return r; }
        i -= T_GU;
        if (i < T_D) { const int tn = i / 44, tk = i % 44, n16 = tn * 64 + 16 * chunk; r.n0 = tn * 64; r.k0 = tk * 64; r.dst = WSP(bf16_t, layer ? WS_WD1 : WS_WD0); r.Kdst = DFF; r.ld = DM;
          r.sp = q->w_down + (size_t)layer * DFF * DM + n16; return r; }
        i -= T_D;
      }
      if (i < T_IN) { const int tn = i / 16, tk = i % 16, n16 = tn * 64 + 16 * chunk; r.n0 = tn * 64; r.k0 = tk * 64; r.dst = WSP(bf16_t, WS_WIN); r.Kdst = DM; r.ld = 3 * DM;
        if (n16 < 2048) r.sp = q->conv_w_in + ((n16 & 128) ? 2048 : 1024) + (n16 >> 8) * 128 + (n16 & 127); else r.sp = q->conv_w_in + (n16 - 2048); return r; }
      i -= T_IN;
      { const int tn = i / 16, tk = i % 16, n16 = tn * 64 + 16 * chunk; r.n0 = tn * 64; r.k0 = tk * 64; r.dst = WSP(bf16_t, WS_WOUT); r.Kdst = DM; r.ld = DM; r.sp = q->conv_w_out + n16; return r; }
    };
    auto load2 = [&](const TItem& I, f32x4& v0, f32x4& v1) { v0 = (f32x4){0.f, 0.f, 0.f, 0.f}; v1 = v0;
      if (I.sp) { v0 = *(const f32x4*)(I.sp + (size_t)(I.k0 + (t >> 4)) * I.ld + cc); v1 = *(const f32x4*)(I.sp + (size_t)(I.k0 + (t >> 4) + 32) * I.ld + cc); } };
    int it = bid;
    if (it < T_TOTAL) {
      TItem cur = decode(it); f32x4 v0, v1; load2(cur, v0, v1);
      for (;;) {
        const int nit = it + G; const bool has = nit < T_TOTAL; TItem nxt = cur; f32x4 n0v = v0, n1v = v1;
        if (has) { nxt = decode(nit); load2(nxt, n0v, n1v); }
        { float* lp = lds_f + (t >> 4) * 65 + chunk * 16 + cc; lp[0] = v0[0]; lp[1] = v0[1]; lp[2] = v0[2]; lp[3] = v0[3];
          lp += 32 * 65; lp[0] = v1[0]; lp[1] = v1[1]; lp[2] = v1[2]; lp[3] = v1[3]; }
        __syncthreads();
        { const int n = t >> 3, kk = (t & 7) * 8; float a[8];
#pragma unroll
          for (int j = 0; j < 8; ++j) a[j] = lds_f[(kk + j) * 65 + n];
          u32x4 w; w.x = pk_bf16(a[0], a[1]); w.y = pk_bf16(a[2], a[3]); w.z = pk_bf16(a[4], a[5]); w.w = pk_bf16(a[6], a[7]);
          *(u32x4*)(cur.dst + (size_t)(cur.n0 + n) * cur.Kdst + cur.k0 + kk) = w; }
        __syncthreads();
        if (!has) break;
        cur = nxt; v0 = n0v; v1 = n1v; it = nit;
      }
    }
  }
  const int gt = bid * 512 + tid, nthr = G * 512;
  { const float* w_ukv = q->w_ukv; const float* w_uq = q->w_uq; bf16_t* Wuq = WSP(bf16_t, WS_WUQ);
  for (int idx = gt; idx < 1536 * 32; idx += nthr) {
    const int n = idx >> 5, jg = (idx & 31) * 8, h = n / 192, c = n % 192; float a[8];
#pragma unroll
    for (int i = 0; i < 8; ++i) a[i] = 0.f;
    if (c < 128) { const float* kr = w_ukv + (size_t)c * 2048 + h * 256;
      for (int d = 0; d < 128; d += 4) { const f32x4 kv = *(const f32x4*)(kr + d);
#pragma unroll
        for (int i = 0; i < 8; ++i) { const f32x4 qv = *(const f32x4*)(w_uq + (size_t)(jg + i) * 1536 + h * 192 + d); a[i] += qv[0] * kv[0] + qv[1] * kv[1] + qv[2] * kv[2] + qv[3] * kv[3]; } }
    } else {
#pragma unroll
      for (int i = 0; i < 8; ++i) a[i] = w_uq[(size_t)(jg + i) * 1536 + n];
    }
    u32x4 w; w.x = pk_bf16(a[0], a[1]); w.y = pk_bf16(a[2], a[3]); w.z = pk_bf16(a[4], a[5]); w.w = pk_bf16(a[6], a[7]);
    *(u32x4*)(Wuq + (size_t)n * 256 + jg) = w;
  } }
  { const float* w_ukv = q->w_ukv; const float* w_o = q->w_o; bf16_t* Wo = WSP(bf16_t, WS_WO);
  for (int idx = gt; idx < 1024 * 128; idx += nthr) {
    const int n = idx & 1023, kg = __builtin_amdgcn_readfirstlane(idx >> 10), h = kg >> 4, c0 = (kg & 15) * 8; float a[8];
#pragma unroll
    for (int i = 0; i < 8; ++i) a[i] = 0.f;
    const float* wop = w_o + (size_t)(h * 128) * DM + n; const float* vr = w_ukv + (size_t)c0 * 2048 + h * 256 + 128;
    for (int d = 0; d < 128; ++d) { const float wv = wop[(size_t)d * DM];
#pragma unroll
      for (int i = 0; i < 8; ++i) a[i] += vr[(size_t)i * 2048 + d] * wv; }
    u32x4 w; w.x = pk_bf16(a[0], a[1]); w.y = pk_bf16(a[2], a[3]); w.z = pk_bf16(a[4], a[5]); w.w = pk_bf16(a[6], a[7]);
    *(u32x4*)(Wo + (size_t)n * DM + h * 128 + c0) = w;
  } }
}

__device__ __forceinline__ void phase_qkv_post(int wsg) {
  ParamsK q = kparams();
  const int tid = opaque_tid(wsg), lane = tid & 63, wid = tid >> 6;
  const int wv = blockIdx.x * 8 + wid, nw = gridDim.x * 8;
  const bf16_t* QKVA = WSP(bf16_t, WS_QKVA); bf16_t* QAN = WSP(bf16_t, WS_QAN); bf16_t* KV = WSP(bf16_t, WS_KV);
  const f32x4 qn = *(const f32x4*)(q->q_norm + lane * 4);
  const float kn0 = q->kv_norm[lane * 2], kn1 = q->kv_norm[lane * 2 + 1];
  const float frev = rope_freq_rev(lane & 15);
  for (int row = wv; row < MALL; row += nw) {
    const bf16_t* rp = QKVA + (size_t)row * 512;
    const u32x2 qa = *(const u32x2*)(rp + lane * 4); const unsigned ka = *(const unsigned*)(rp + 256 + lane * 2); const float kr = bf_lo((unsigned)rp[384 + lane]);
    const float q0 = bf_lo(qa.x), q1 = bf_hi(qa.x), q2 = bf_lo(qa.y), q3 = bf_hi(qa.y), k0 = bf_lo(ka), k1 = bf_hi(ka);
    const float qss = wave_sum(q0 * q0 + q1 * q1 + q2 * q2 + q3 * q3), kss = wave_sum(k0 * k0 + k1 * k1);
    const float qr = rsqrtf(qss * (1.0f / 256.0f) + NORM_EPS), krs = rsqrtf(kss * (1.0f / 128.0f) + NORM_EPS);
    size_t kvrow; float kro = kr;
    if (row < MLAT) { const int b = row / SEQ, t = row % SEQ; kvrow = (size_t)b * SKV + CTX + t;
      u32x2 o; o.x = pk_bf16(q0 * qr * qn[0], q1 * qr * qn[1]); o.y = pk_bf16(q2 * qr * qn[2], q3 * qr * qn[3]);
      *(u32x2*)(QAN + (size_t)row * 256 + lane * 4) = o;
      const float pos = (float)(lane < 32 ? (t >> 6) : (t & 63)); float s, c; sincos_rev(pos * frev, s, c);
      const float xp = __shfl_xor(kr, 16);
      kro = (lane & 16) ? kr * c + xp * s : kr * c - xp * s;
    } else { const int r2 = row - MLAT; kvrow = (size_t)(r2 / CTX) * SKV + (r2 % CTX); }
    bf16_t* kp = KV + kvrow * DQK;
    *(unsigned*)(kp + lane * 2) = pk_bf16(k0 * krs * kn0, k1 * krs * kn1);
    kp[128 + lane] = (bf16_t)(pk_bf16(kro, 0.f) & 0xffffu);
  }
}

__device__ __forceinline__ void phase_attn(int wsg, unsigned char* shm) {
  ParamsK q = kparams();
  const bf16_t* Qb = WSP(bf16_t, WS_Q); const bf16_t* KV = WSP(bf16_t, WS_KV); bf16_t* Ob = WSP(bf16_t, WS_O);
  for (int u = blockIdx.x; u < NB * NH * (SEQ / 256); u += gridDim.x) {
    const int w = u & 255, r = u >> 8, xcd = w & 7, slot = w >> 3;
    const int b = xcd >> 1, idx = (xcd & 1) * 128 + r * 32 + slot, h = idx >> 5, qb = idx & 31;
    __syncthreads();
    att::attn_unit(wsg, Qb + ((size_t)(b * SEQ + qb * 256) * 1536 + h * DQK), KV + (size_t)b * SKV * DQK, Ob + ((size_t)(b * SEQ + qb * 256) * DM + h * 128), (LAS unsigned char*)shm);
  }
}

__device__ __forceinline__ void phase_conv(int wsg) {
  ParamsK q = kparams();
  const int tid = opaque_tid(wsg);
  const bf16_t* CV = WSP(bf16_t, WS_CV); const bf16_t* BG = WSP(bf16_t, WS_BG); bf16_t* Z = WSP(bf16_t, WS_Z);
  const float* cw = q->conv_w;
  const size_t nitem = (size_t)MLAT * DM / 8;
  for (size_t it = (size_t)blockIdx.x * 512 + tid; it < nitem; it += (size_t)gridDim.x * 512) {
    const int row = (int)(it >> 7), d0 = (int)(it & 127) * 8, t = row & (SEQ - 1);
    const u32x4 cur = *(const u32x4*)(CV + (size_t)row * DM + d0);
    u32x4 prv = (u32x4){0u, 0u, 0u, 0u}, nxt = (u32x4){0u, 0u, 0u, 0u};
    if (t > 0) prv = *(const u32x4*)(CV + (size_t)(row - 1) * DM + d0);
    if (t < SEQ - 1) nxt = *(const u32x4*)(CV + (size_t)(row + 1) * DM + d0);
    const u32x4 bg = *(const u32x4*)(BG + (size_t)row * DM + d0);
    const float* w0 = cw + d0; const float* w1 = cw + DM + d0; const float* w2 = cw + 2 * DM + d0;
    u32x4 o;
#pragma unroll
    for (int k = 0; k < 4; ++k) {
      const float ul = w0[2 * k] * bf_lo(prv[k]) + w1[2 * k] * bf_lo(cur[k]) + w2[2 * k] * bf_lo(nxt[k]);
      const float uh = w0[2 * k + 1] * bf_hi(prv[k]) + w1[2 * k + 1] * bf_hi(cur[k]) + w2[2 * k + 1] * bf_hi(nxt[k]);
      o[k] = pk_bf16(bf_lo(bg[k]) * ul, bf_hi(bg[k]) * uh); }
    *(u32x4*)(Z + (size_t)row * DM + d0) = o;
  }
}

#define GEMM_SETUP(M_, N_) ParamsK q = kparams(); pg8::StaticOrder S; S.init((M_), (N_), gridDim.x, blockIdx.x); LAS unsigned char* ldsl = (LAS unsigned char*)shm
__device__ __forceinline__ void phase_gemm_qkva(int wsg, unsigned char* shm) { GEMM_SETUP(MALL, 512);
  pg8::Gemm g{WSP(bf16_t, WS_H), WSP(bf16_t, WS_WQKVA), MALL, 512, DM}; pg8::EpiBf16 E{WSP(bf16_t, WS_QKVA), 512}; pg8::gemm_phase(wsg, ldsl, g, S, E); }
__device__ __forceinline__ void phase_gemm_uq(int wsg, unsigned char* shm) { GEMM_SETUP(MLAT, 1536);
  pg8::Gemm g{WSP(bf16_t, WS_QAN), WSP(bf16_t, WS_WUQ), MLAT, 1536, 256}; pg8::EpiQRope E{WSP(bf16_t, WS_Q)}; pg8::gemm_phase(wsg, ldsl, g, S, E); }
__device__ __forceinline__ void phase_gemm_mixout0(int wsg, unsigned char* shm) { GEMM_SETUP(MLAT, DM);
  pg8::Gemm g{WSP(bf16_t, WS_O), WSP(bf16_t, WS_WO), MLAT, DM, DM};
  pg8::EpiResid<true> E{q->x, WSP(bf16_t, WS_X16), WSP(float, WS_MOD) + 2048}; pg8::gemm_phase(wsg, ldsl, g, S, E); }
__device__ __forceinline__ void phase_gemm_mixout1(int wsg, unsigned char* shm) { GEMM_SETUP(MLAT, DM);
  pg8::Gemm g{WSP(bf16_t, WS_Z), WSP(bf16_t, WS_WOUT), MLAT, DM, DM};
  pg8::EpiResid<false> E{WSP(bf16_t, WS_X16), WSP(bf16_t, WS_X16), WSP(float, WS_MOD) + (size_t)5 * 6144 + 2048}; pg8::gemm_phase(wsg, ldsl, g, S, E); }
__device__ __forceinline__ void phase_gemm_convin(int wsg, unsigned char* shm) { GEMM_SETUP(MLAT, 3 * DM);
  pg8::Gemm g{WSP(bf16_t, WS_H), WSP(bf16_t, WS_WIN), MLAT, 3 * DM, DM}; pg8::EpiConvIn E{WSP(bf16_t, WS_CV), WSP(bf16_t, WS_BG)}; pg8::gemm_phase<decltype(E), true, true>(wsg, ldsl, g, S, E); }
__device__ __forceinline__ void phase_gemm_gu(int wsg, unsigned char* shm, int layer) { GEMM_SETUP(MLAT, 2 * DFF);
  pg8::Gemm g{WSP(bf16_t, WS_H), WSP(bf16_t, layer ? WS_WGU1 : WS_WGU0), MLAT, 2 * DFF, DM}; pg8::EpiSwiglu E{WSP(bf16_t, WS_G), DFF}; pg8::gemm_phase<decltype(E), true, true>(wsg, ldsl, g, S, E); }
__device__ __forceinline__ void phase_gemm_down(int wsg, unsigned char* shm, int layer) { GEMM_SETUP(MLAT, DM);
  pg8::Gemm g{WSP(bf16_t, WS_G), WSP(bf16_t, layer ? WS_WD1 : WS_WD0), MLAT, DM, DFF};
  pg8::EpiResid<false> E{WSP(bf16_t, WS_X16), WSP(bf16_t, WS_X16), WSP(float, WS_MOD) + (size_t)layer * 5 * 6144 + 5120}; pg8::gemm_phase<decltype(E), true, true>(wsg, ldsl, g, S, E); }

#define XB_TMO      128
#define XB_XCNT(j)  (256  + 64 * (j))
#define XB_XSUB(j)  (1280 + 64 * (j))
#define XB_XGEN(j)  (2304 + 64 * (j))
#define XB_TOP      3328
#define XB_TOPGEN   3392
#define XB_SPIN_CAP (1u << 20)
constexpr int LDS_XB = LDS_BYTES - 16;
__device__ __forceinline__ unsigned xb_ld(unsigned* p)              { return __hip_atomic_load(p, __ATOMIC_RELAXED, __HIP_MEMORY_SCOPE_AGENT); }
__device__ __forceinline__ unsigned xb_add(unsigned* p, unsigned v) { return __hip_atomic_fetch_add(p, v, __ATOMIC_RELAXED, __HIP_MEMORY_SCOPE_AGENT); }
__device__ __forceinline__ unsigned xb_xcc_id() { return (unsigned)__builtin_amdgcn_s_getreg((3 << 11) | 20) & 0xFu; }
#define XB_SPIN(cond, bar) do { unsigned _sp = 0; while (cond) { __builtin_amdgcn_s_sleep(1); \
    if ((++_sp & 255u) == 0u) { if (xb_ld(&(bar)[XB_TMO])) break; if (_sp > XB_SPIN_CAP) { atomicAdd(&(bar)[XB_TMO], 1u); break; } } } } while (0)
__device__ __forceinline__ void xcd_barrier_complete(unsigned* bar, unsigned x, unsigned& nloc, unsigned& nx) {
  const unsigned G = gridDim.x;
  unsigned sum, cnt, mine, sp = 0u;
  for (;;) {
    sum = 0u; cnt = 0u; mine = 0u;
#pragma unroll
    for (unsigned j = 0; j < 16; ++j) { const unsigned c = xb_ld(&bar[XB_XCNT(j)]); sum += c; cnt += (c > 0u) ? 1u : 0u; mine = (j == x) ? c : mine; }
    if (sum == G) break;
    __builtin_amdgcn_s_sleep(1);
    if ((++sp & 255u) == 0u) { if (xb_ld(&bar[XB_TMO])) break; if (sp > XB_SPIN_CAP) { atomicAdd(&bar[XB_TMO], 1u); break; } }
  }
  nloc = mine > 0u ? mine : 1u; nx = cnt > 0u ? cnt : 1u;
}
__device__ __forceinline__ void grid_bar_post(int wsg, unsigned char* shm) {
  ParamsK q = kparams(); unsigned* bar = (unsigned*)q->ws; const unsigned x = xb_xcc_id();
  if (opaque_tid(wsg) == 0) { volatile LAS unsigned* st = (volatile LAS unsigned*)((LAS unsigned char*)shm + LDS_XB); st[0] = 0u; st[1] = 0u;
    (void)xb_add(&bar[XB_XCNT(x)], 1u); }
  __syncthreads();
}
__device__ __forceinline__ void grid_bar(int wsg, unsigned char* shm) {
  asm volatile("s_waitcnt vmcnt(0)" ::: "memory");
  __syncthreads();
  ParamsK q = kparams(); unsigned* bar = (unsigned*)q->ws; const unsigned x = xb_xcc_id();
  if (opaque_tid(wsg) == 0) {
    volatile LAS unsigned* st = (volatile LAS unsigned*)((LAS unsigned char*)shm + LDS_XB);
    __builtin_amdgcn_s_waitcnt(0);
    unsigned nloc = st[0], nx = st[1];
    if (nloc == 0u) { xcd_barrier_complete(bar, x, nloc, nx); st[0] = nloc; st[1] = nx; }
    const unsigned old = xb_add(&bar[XB_XSUB(x)], 1u);
    const unsigned gen = old / nloc;
    if (old + 1u == (gen + 1u) * nloc) {
      __builtin_amdgcn_fence(__ATOMIC_RELEASE, "agent");
      asm volatile("s_waitcnt vmcnt(0)" ::: "memory");
      const unsigned og = xb_add(&bar[XB_TOP], 1u);
      const unsigned tg = og / nx;
      if (og + 1u == (tg + 1u) * nx) xb_add(&bar[XB_TOPGEN], 1u);
      else XB_SPIN(xb_ld(&bar[XB_TOPGEN]) == tg, bar);
      __builtin_amdgcn_fence(__ATOMIC_ACQUIRE, "agent");
      xb_add(&bar[XB_XGEN(x)], 1u);
      asm volatile("s_waitcnt vmcnt(0)" ::: "memory");
    } else {
      XB_SPIN(xb_ld(&bar[XB_XGEN(x)]) == gen, bar);
      __builtin_amdgcn_fence(__ATOMIC_ACQUIRE, "agent");
      asm volatile("s_waitcnt vmcnt(0)" ::: "memory");
    }
  }
  __syncthreads();
}


__device__ __forceinline__ void phase_norm_mix0(int wsg) { ParamsK q = kparams();
  norm_rows<false, false>(wsg, q->x, q->ctx, nullptr, MALL, q->norm_mix, WSP(float, WS_MOD), 0, 1024, WSP(bf16_t, WS_H), nullptr); }
__device__ __forceinline__ void phase_norm_mix1(int wsg) { ParamsK q = kparams();
  norm_rows<false, true>(wsg, nullptr, nullptr, WSP(bf16_t, WS_X16), MLAT, q->norm_mix + DM, WSP(float, WS_MOD) + (size_t)5 * 6144, 0, 1024, WSP(bf16_t, WS_H), nullptr); }
template <int LAYER> __device__ __forceinline__ void phase_norm_ffn(int wsg) { ParamsK q = kparams();
  norm_rows<false, true>(wsg, nullptr, nullptr, WSP(bf16_t, WS_X16), MLAT, q->norm_ffn + LAYER * DM, WSP(float, WS_MOD) + (size_t)LAYER * 5 * 6144, 3072, 4096, WSP(bf16_t, WS_H), nullptr); }

__global__ void __launch_bounds__(512, 2) mk_fwd(Params p) {
  extern __shared__ __attribute__((aligned(16))) unsigned char shm[];
  cg::grid_group grid = cg::this_grid();
  const int wsg = __builtin_amdgcn_readfirstlane((int)(threadIdx.x >> 6));
  grid_bar_post(wsg, shm);
  phase_adaln(wsg, shm);
  grid.sync();
  phase_norm_mix0(wsg); phase_prologue(wsg, shm); grid_bar(wsg, shm);
  phase_gemm_qkva(wsg, shm); grid_bar(wsg, shm);
  phase_qkv_post(wsg); grid_bar(wsg, shm);
  phase_gemm_uq(wsg, shm); grid_bar(wsg, shm);
  phase_attn(wsg, shm); grid_bar(wsg, shm);
  phase_gemm_mixout0(wsg, shm); grid_bar(wsg, shm);
  phase_norm_ffn<0>(wsg); grid_bar(wsg, shm);
  phase_gemm_gu(wsg, shm, 0); grid_bar(wsg, shm);
  phase_gemm_down(wsg, shm, 0); grid_bar(wsg, shm);
  phase_norm_mix1(wsg); grid_bar(wsg, shm);
  phase_gemm_convin(wsg, shm); grid_bar(wsg, shm);
  phase_conv(wsg); grid_bar(wsg, shm);
  phase_gemm_mixout1(wsg, shm); grid_bar(wsg, shm);
  phase_norm_ffn<1>(wsg); grid_bar(wsg, shm);
  phase_gemm_gu(wsg, shm, 1); grid_bar(wsg, shm);
  phase_gemm_down(wsg, shm, 1); grid_bar(wsg, shm);
  { ParamsK q = kparams(); norm_rows<true, true>(wsg, nullptr, nullptr, WSP(bf16_t, WS_X16), MLAT, q->final_norm, nullptr, 0, 0, nullptr, q->out); }
}

extern "C" void kernel_launch(void* const* d_in, const int* in_sizes, int n_in, void* d_out, int out_size, void* d_ws, size_t ws_size, hipStream_t stream) {
  static int grid_blocks = 0;
  if (!grid_blocks) {
    if (ws_size < WS_END) { fprintf(stderr, "kernel_launch: ws too small %zu < %zu\n", ws_size, (size_t)WS_END); return; }
    if (hipFuncSetAttribute((const void*)mk_fwd, hipFuncAttributeMaxDynamicSharedMemorySize, LDS_BYTES) != hipSuccess) { fprintf(stderr, "kernel_launch: set LDS attr failed\n"); return; }
    int dev = 0, cus = 0, per_cu = 0;
    (void)hipGetDevice(&dev);
    (void)hipDeviceGetAttribute(&cus, hipDeviceAttributeMultiprocessorCount, dev);
    (void)hipOccupancyMaxActiveBlocksPerMultiprocessor(&per_cu, mk_fwd, 512, LDS_BYTES);
    if (per_cu < 1) { fprintf(stderr, "kernel_launch: occupancy 0\n"); return; }
    grid_blocks = cus;
  }
  Params p{};
  p.x = (const float*)d_in[0]; p.c = (const float*)d_in[1]; p.ctx = (const float*)d_in[2]; p.c_ctx = (const float*)d_in[3];
  p.ada_w = (const float*)d_in[4]; p.ada_b = (const float*)d_in[5]; p.norm_mix = (const float*)d_in[6]; p.norm_ffn = (const float*)d_in[7];
  p.w_dq = (const float*)d_in[8]; p.q_norm = (const float*)d_in[9]; p.w_uq = (const float*)d_in[10]; p.w_dkv = (const float*)d_in[11];
  p.kv_norm = (const float*)d_in[12]; p.w_ukv = (const float*)d_in[13]; p.w_o = (const float*)d_in[14];
  p.conv_w_in = (const float*)d_in[15]; p.conv_w = (const float*)d_in[16]; p.conv_w_out = (const float*)d_in[17];
  p.w_gate = (const float*)d_in[18]; p.w_up = (const float*)d_in[19]; p.w_down = (const float*)d_in[20]; p.final_norm = (const float*)d_in[21];
  p.out = (float*)d_out; p.ws = (unsigned char*)d_ws;
  void* args[] = {&p};
  (void)hipMemsetAsync(d_ws, 0, 16384, stream);
  hipError_t e = hipLaunchCooperativeKernel((void*)mk_fwd, dim3(grid_blocks), dim3(512), args, LDS_BYTES, stream);
  if (e != hipSuccess) fprintf(stderr, "cooperative launch failed: %s (grid %d)\n", hipGetErrorString(e), grid_blocks);
}
```

```cpp
#include <hip/hip_runtime.h>
#include <hip/hip_cooperative_groups.h>
#include <cstdio>
#include <cstdint>
namespace cg = cooperative_groups;

typedef unsigned short bf16_t;
typedef short bf16x8 __attribute__((ext_vector_type(8)));
typedef short s16x4 __attribute__((ext_vector_type(4)));
typedef float f32x4 __attribute__((ext_vector_type(4)));
typedef float f32x16 __attribute__((ext_vector_type(16)));
typedef unsigned u32x4 __attribute__((ext_vector_type(4)));
typedef unsigned u32x2 __attribute__((ext_vector_type(2)));
#define LAS __attribute__((address_space(3)))

constexpr int DM = 1024, NB = 4, SEQ = 8192, CTX = 256, NH = 8, DFF = 2816;
constexpr int MLAT = NB * SEQ;
constexpr int MCTX = NB * CTX;
constexpr int MALL = MLAT + MCTX;
constexpr int SKV = CTX + SEQ;
constexpr int DQK = 192;
constexpr float NORM_EPS = 1e-6f;

constexpr size_t MiB = 1u << 20;
constexpr size_t WS_MOD = 1 * MiB;
constexpr size_t WS_WQKVA = 2 * MiB;
constexpr size_t WS_WUQ = 3 * MiB;
constexpr size_t WS_WO = 4 * MiB;
constexpr size_t WS_WGU0 = 6 * MiB;
constexpr size_t WS_WD0 = 17 * MiB;
constexpr size_t WS_WIN = 23 * MiB;
constexpr size_t WS_WOUT = 29 * MiB;
constexpr size_t WS_WGU1 = 31 * MiB;
constexpr size_t WS_WD1 = 42 * MiB;
constexpr size_t WS_H = 48 * MiB;
constexpr size_t WS_BIG = 116 * MiB;
constexpr size_t WS_QKVA = WS_BIG;
constexpr size_t WS_QAN = WS_BIG + 33 * MiB;
constexpr size_t WS_KV = WS_BIG + 49 * MiB;
constexpr size_t WS_Q = WS_BIG + 64 * MiB;
constexpr size_t WS_O = WS_BIG + 160 * MiB;
constexpr size_t WS_G = WS_BIG;
constexpr size_t WS_CV = WS_BIG;
constexpr size_t WS_BG = WS_BIG + 64 * MiB;
constexpr size_t WS_Z = WS_BIG + 128 * MiB;
constexpr size_t WS_X16 = WS_BIG + 224 * MiB;
constexpr size_t WS_END = WS_BIG + 288 * MiB;
static_assert(WS_KV + (size_t)NB * SKV * DQK * 2 <= WS_Q && WS_QAN + (size_t)MLAT * 256 * 2 <= WS_KV && WS_QKVA + (size_t)MALL * 512 * 2 <= WS_QAN && WS_Q + (size_t)MLAT * 1536 * 2 <= WS_O && WS_O + (size_t)MLAT * DM * 2 <= WS_END && WS_G + (size_t)MLAT * DFF * 2 <= WS_END && WS_H + (size_t)MALL * DM * 2 <= WS_BIG, "ws map");

constexpr int LDS_BYTES = 163840;

typedef float f32x2_t __attribute__((ext_vector_type(2)));
typedef __bf16 bf16x2_t __attribute__((ext_vector_type(2)));
__device__ __forceinline__ unsigned pk_bf16(float lo, float hi) { const f32x2_t v = {lo, hi}; const bf16x2_t b = __builtin_convertvector(v, bf16x2_t); return __builtin_bit_cast(unsigned, b); }
__device__ __forceinline__ float bf_lo(unsigned u) { return __uint_as_float(u << 16); }
__device__ __forceinline__ float bf_hi(unsigned u) { return __uint_as_float(u & 0xffff0000u); }
__device__ __forceinline__ float wave_sum(float v) {
#pragma unroll
  for (int o = 32; o >= 1; o >>= 1) v += __shfl_xor(v, o);
  return v;
}
__device__ __forceinline__ int opaque_tid(int wsg) { int t; asm volatile("v_mbcnt_lo_u32_b32 %0, -1, 0\n\tv_mbcnt_hi_u32_b32 %0, -1, %0\n\tv_lshl_or_b32 %0, %1, 6, %0" : "=&v"(t) : "s"(wsg)); return t; }
__device__ __forceinline__ float silu_f(float x) { return x / (1.0f + __expf(-x)); }
__device__ __forceinline__ float rope_freq_rev(int i) { return __builtin_amdgcn_exp2f(-(float)i * (13.287712379549449f / 16.0f)) * 0.15915494309189535f; }
__device__ __forceinline__ void sincos_rev(float rev, float& s, float& c) { float f = rev - floorf(rev); s = __builtin_amdgcn_sinf(f); c = __builtin_amdgcn_cosf(f); }

namespace pg8 {
constexpr int BM = 256, BK = 64, HALF = 128, HTB = HALF * BK * 2, STAGE_BYTES = 8 * HTB, NXCD = 8, WGM = 8;
__device__ __forceinline__ int lds_byte(int r, int c) { const int st = (r >> 4) * 2 + (c >> 5), rr = r & 15, cc = c & 31, ob = rr * 64 + cc * 2; return st * 1024 + (ob ^ (((ob >> 9) & 1) << 5)); }
__device__ __forceinline__ void stage_rc(int b, int& R, int& C) { const int st = b / 1024, sb = b % 1024, swz = sb ^ (((sb >> 9) & 1) << 5); R = (st >> 1) * 16 + swz / 64; C = (st & 1) * 32 + (swz % 64) / 2; }
__device__ __forceinline__ int perm32(int rho) { const int n = rho >> 4, i = rho & 15; return 8 * (i >> 2) + 4 * n + (i & 3); }
struct Unit { int pm, pn; };
struct Gemm { const bf16_t* A; const bf16_t* Bt; int M, N, K; };
struct StaticOrder {
  int nM, nN, nwg, G, c;
  __device__ void init(int M, int N, int G_, int c_) { nM = M / BM; nN = N / BM; nwg = nM * nN; G = G_; c = c_; }
  __device__ bool next(int i, Unit& u) const {
    const long L = (long)i * G + c; if (L >= nwg) return false;
    int wgid = (int)L; { const int q = nwg / NXCD, r = nwg % NXCD, xcd = wgid % NXCD, off = wgid / NXCD; wgid = (xcd < r ? xcd * (q + 1) : r * (q + 1) + (xcd - r) * q) + off; }
    const int nig = WGM * nN, gid = wgid / nig, fm = gid * WGM, gsz = (nM - fm) < WGM ? (nM - fm) : WGM;
    u.pm = fm + ((wgid % nig) % gsz); u.pn = (wgid % nig) / gsz; return true;
  }
};

template <class Epi, bool ALIGN_EPI = true, bool SP2 = false>
__device__ __forceinline__ void gemm_phase(int wsg, LAS unsigned char* lds, const Gemm g, const StaticOrder& S, const Epi& E) {
  const int tid = opaque_tid(wsg), wid = __builtin_amdgcn_readfirstlane(tid >> 6), lane = tid & 63, wr = wid >> 2, wc = wid & 3, fr = lane & 15, fq = lane >> 4;
  const int K = g.K, nt = K / BK;
  unsigned voffA[2], voffB[2];
#pragma unroll
  for (int i = 0; i < 2; ++i) { int R, C; stage_rc(tid * 16 + i * 8192, R, C); const int Rb = Epi::PERM ? ((R & ~31) + perm32(R & 31)) : R;
    voffA[i] = (unsigned)(R * K + C) * 2u; voffB[i] = (unsigned)(Rb * K + C) * 2u; }
  const size_t kstep = (size_t)(BK * 2);
  const size_t hstep = (size_t)HALF * K * 2;
  const size_t tstep = 2 * hstep;
  const unsigned ldsw = (unsigned)wid * 1024u;
  const int aoff = lds_byte(wr * 64 + fr, fq * 8), boff = lds_byte(wc * 32 + fr, fq * 8);
#define PG8_SA(b, h) (((b) * 2 + (h)) * HTB)
#define PG8_SB(b, h) ((4 + (b) * 2 + (h)) * HTB)
#define PG8_STAGE(bufoff, gbase, voff) do { _Pragma("unroll") for (int _i = 0; _i < 2; ++_i) \
    __builtin_amdgcn_global_load_lds((const unsigned*)((const char*)(gbase) + (voff)[_i]), (LAS unsigned*)(lds + (bufoff) + ldsw + _i * 8192), 16, 0, 0); } while (0)
#define PG8_LDA(dst, b, h) do { _Pragma("unroll") for (int m = 0; m < 4; ++m) _Pragma("unroll") for (int k = 0; k < 2; ++k) dst[m][k] = *(const LAS bf16x8*)(lds + PG8_SA(b, h) + aoff + m * 2048 + k * 1024); } while (0)
#define PG8_LDB(dst, b, h) do { _Pragma("unroll") for (int n = 0; n < 2; ++n) _Pragma("unroll") for (int k = 0; k < 2; ++k) dst[n][k] = *(const LAS bf16x8*)(lds + PG8_SB(b, h) + boff + n * 2048 + k * 1024); } while (0)
#define PG8_MMA(ai, bj, At, Bt) do { __builtin_amdgcn_s_setprio(1); _Pragma("unroll") for (int m = 0; m < 4; ++m) _Pragma("unroll") for (int n = 0; n < 2; ++n) _Pragma("unroll") for (int k = 0; k < 2; ++k) \
    acc[ai][bj][m][n] = __builtin_amdgcn_mfma_f32_16x16x32_bf16(Bt[n][k], At[m][k], acc[ai][bj][m][n], 0, 0, 0); __builtin_amdgcn_s_setprio(0); } while (0)
#define PG8_WAIT_V(n) asm volatile("s_waitcnt vmcnt(" #n ")" ::: "memory")
#define PG8_WAIT_L(n) asm volatile("s_waitcnt lgkmcnt(" #n ")" ::: "memory")
#define PG8_BAR __builtin_amdgcn_s_barrier()
#define PG8_SCHED __builtin_amdgcn_sched_barrier(0)
  Unit cur, nxt; int ui = 0;
  if (!S.next(0, cur)) return;
  f32x4 acc[2][2][4][2];
#pragma unroll
  for (int a = 0; a < 2; ++a)
#pragma unroll
    for (int b = 0; b < 2; ++b)
#pragma unroll
      for (int m = 0; m < 4; ++m)
#pragma unroll
        for (int n = 0; n < 2; ++n) acc[a][b][m][n] = (f32x4){0.f, 0.f, 0.f, 0.f};
  bf16x8 At[4][2], B0[2][2], B1[2][2];
  const char* cA = (const char*)g.A + (size_t)cur.pm * tstep; const char* cB = (const char*)g.Bt + (size_t)cur.pn * tstep;
  if constexpr (SP2) {
    PG8_STAGE(PG8_SB(0, 0), cB, voffB); PG8_STAGE(PG8_SB(0, 1), cB + hstep, voffB); PG8_STAGE(PG8_SA(0, 0), cA, voffA); PG8_STAGE(PG8_SA(0, 1), cA + hstep, voffA);
    if (wr == 1) PG8_BAR;
    PG8_WAIT_V(2); PG8_BAR;
    PG8_STAGE(PG8_SB(1, 0), cB + kstep, voffB); PG8_STAGE(PG8_SA(1, 0), cA + kstep, voffA); PG8_STAGE(PG8_SB(1, 1), cB + hstep + kstep, voffB);
    PG8_WAIT_V(6); PG8_BAR;
  } else {
    PG8_STAGE(PG8_SB(0, 0), cB, voffB); PG8_STAGE(PG8_SA(0, 0), cA, voffA); PG8_STAGE(PG8_SB(0, 1), cB + hstep, voffB); PG8_STAGE(PG8_SA(0, 1), cA + hstep, voffA);
    if (wr == 1) PG8_BAR;
    PG8_WAIT_V(4); PG8_BAR;
    PG8_STAGE(PG8_SB(1, 0), cB + kstep, voffB); PG8_STAGE(PG8_SA(1, 0), cA + kstep, voffA); PG8_STAGE(PG8_SB(1, 1), cB + hstep + kstep, voffB);
    PG8_WAIT_V(6); PG8_BAR;
  }
  for (;;) {
    const bool has_next = S.next(ui + 1, nxt);
    const char* nA = has_next ? (const char*)g.A + (size_t)nxt.pm * tstep : cA; const char* nB = has_next ? (const char*)g.Bt + (size_t)nxt.pn * tstep : cB;
    for (int t = 0; t < nt; t += 2) {
      const bool last = (t == nt - 2);
      const char* a1 = cA + (size_t)(t + 1) * kstep;
      const char* a2 = last ? nA : cA + (size_t)(t + 2) * kstep; const char* b2 = last ? nB : cB + (size_t)(t + 2) * kstep;
      const char* a3 = a2 + kstep; const char* b3 = b2 + kstep;
      if constexpr (SP2) {
      PG8_LDB(B0, 0, 0); PG8_LDB(B1, 0, 1); PG8_SCHED; PG8_LDA(At, 0, 0); PG8_STAGE(PG8_SA(1, 1), a1 + hstep, voffA);
      PG8_WAIT_V(8); PG8_WAIT_L(0); PG8_BAR; PG8_MMA(0, 0, At, B0); PG8_MMA(0, 1, At, B1); PG8_BAR; PG8_SCHED;
      PG8_LDA(At, 0, 1); PG8_STAGE(PG8_SB(0, 0), b2, voffB); PG8_STAGE(PG8_SB(0, 1), b2 + hstep, voffB); PG8_STAGE(PG8_SA(0, 0), a2, voffA);
      PG8_WAIT_V(8); PG8_WAIT_L(0); PG8_BAR; PG8_MMA(1, 0, At, B0); PG8_MMA(1, 1, At, B1); PG8_BAR; PG8_SCHED;
      PG8_LDB(B0, 1, 0); PG8_LDB(B1, 1, 1); PG8_SCHED; PG8_LDA(At, 1, 0); PG8_STAGE(PG8_SA(0, 1), a2 + hstep, voffA);
      PG8_WAIT_V(8); PG8_WAIT_L(0); PG8_BAR; PG8_MMA(0, 0, At, B0); PG8_MMA(0, 1, At, B1); PG8_BAR; PG8_SCHED;
      PG8_LDA(At, 1, 1); PG8_STAGE(PG8_SB(1, 0), b3, voffB); PG8_STAGE(PG8_SB(1, 1), b3 + hstep, voffB); PG8_STAGE(PG8_SA(1, 0), a3, voffA);
      PG8_WAIT_V(8); PG8_WAIT_L(0); PG8_BAR; PG8_MMA(1, 0, At, B0); PG8_MMA(1, 1, At, B1); PG8_BAR; PG8_SCHED;
      } else {
      PG8_LDB(B0, 0, 0); PG8_SCHED; PG8_LDA(At, 0, 0); PG8_STAGE(PG8_SA(1, 1), a1 + hstep, voffA);
      PG8_WAIT_L(8); PG8_BAR; PG8_WAIT_L(0); PG8_MMA(0, 0, At, B0); PG8_BAR; PG8_SCHED;
      PG8_LDB(B1, 0, 1); PG8_STAGE(PG8_SB(0, 0), b2, voffB);
      PG8_BAR; PG8_WAIT_L(0); PG8_MMA(0, 1, At, B1); PG8_BAR;
      PG8_LDA(At, 0, 1); PG8_STAGE(PG8_SA(0, 0), a2, voffA);
      PG8_BAR; PG8_WAIT_L(0); PG8_MMA(1, 0, At, B0); PG8_BAR; PG8_SCHED;
      PG8_STAGE(PG8_SB(0, 1), b2 + hstep, voffB);
      PG8_WAIT_V(6); PG8_BAR; PG8_MMA(1, 1, At, B1); PG8_BAR;
      PG8_LDB(B0, 1, 0); PG8_SCHED; PG8_LDA(At, 1, 0); PG8_STAGE(PG8_SA(0, 1), a2 + hstep, voffA);
      PG8_WAIT_L(8); PG8_BAR; PG8_WAIT_L(0); PG8_MMA(0, 0, At, B0); PG8_BAR; PG8_SCHED;
      PG8_LDB(B1, 1, 1); PG8_STAGE(PG8_SB(1, 0), b3, voffB);
      PG8_BAR; PG8_WAIT_L(0); PG8_MMA(0, 1, At, B1); PG8_BAR;
      PG8_LDA(At, 1, 1); PG8_STAGE(PG8_SA(1, 0), a3, voffA);
      PG8_BAR; PG8_WAIT_L(0); PG8_MMA(1, 0, At, B0); PG8_BAR; PG8_SCHED;
      PG8_STAGE(PG8_SB(1, 1), b3 + hstep, voffB);
      PG8_WAIT_V(6); PG8_BAR; PG8_MMA(1, 1, At, B1); PG8_BAR;
      }
    }
    if constexpr (ALIGN_EPI) { if (wr == 0) PG8_BAR; }
    E(acc, cur, wr, wc, fr, fq);
    if (!has_next) break;
#pragma unroll
    for (int a = 0; a < 2; ++a)
#pragma unroll
      for (int b = 0; b < 2; ++b)
#pragma unroll
        for (int m = 0; m < 4; ++m)
#pragma unroll
          for (int n = 0; n < 2; ++n) acc[a][b][m][n] = (f32x4){0.f, 0.f, 0.f, 0.f};
    cur = nxt; cA = nA; cB = nB; ++ui;
    if constexpr (ALIGN_EPI) { if (wr == 1) PG8_BAR; }
  }
  PG8_WAIT_V(0);
  if constexpr (!ALIGN_EPI) { if (wr == 0) PG8_BAR; }
  PG8_BAR;
#undef PG8_SA
#undef PG8_SB
#undef PG8_STAGE
#undef PG8_LDA
#undef PG8_LDB
#undef PG8_MMA
#undef PG8_WAIT_V
#undef PG8_WAIT_L
#undef PG8_BAR
#undef PG8_SCHED
}

struct EpiBf16 {
  static constexpr bool PERM = true;
  bf16_t* O; int ldc;
  __device__ __forceinline__ void operator()(const f32x4 (&acc)[2][2][4][2], const Unit& u, int wr, int wc, int fr, int fq) const {
    const int row0 = u.pm * BM + wr * 64 + fr, col0 = u.pn * BM + wc * 32 + 8 * fq;
#pragma unroll
    for (int ai = 0; ai < 2; ++ai)
#pragma unroll
      for (int m = 0; m < 4; ++m) { bf16_t* rowp = O + (size_t)(row0 + ai * HALF + m * 16) * ldc + col0;
#pragma unroll
        for (int bj = 0; bj < 2; ++bj) { const f32x4 v0 = acc[ai][bj][m][0], v1 = acc[ai][bj][m][1];
          u32x4 w; w.x = pk_bf16(v0[0], v0[1]); w.y = pk_bf16(v0[2], v0[3]); w.z = pk_bf16(v1[0], v1[1]); w.w = pk_bf16(v1[2], v1[3]);
          *(u32x4*)(rowp + bj * HALF) = w; } }
  }
};
struct EpiQRope {
  static constexpr bool PERM = false;
  bf16_t* O;
  __device__ __forceinline__ void operator()(const f32x4 (&acc)[2][2][4][2], const Unit& u, int wr, int wc, int fr, int fq) const {
    const int row0 = u.pm * BM + wr * 64 + fr;
    float fr_rev[4];
#pragma unroll
    for (int j = 0; j < 4; ++j) fr_rev[j] = rope_freq_rev(4 * fq + j);
#pragma unroll
    for (int bj = 0; bj < 2; ++bj) {
      const int gq = u.pn * 8 + bj * 4 + wc;
      const int within = gq % 6;
      const int col0 = gq * 32 + 4 * fq;
#pragma unroll
      for (int ai = 0; ai < 2; ++ai)
#pragma unroll
        for (int m = 0; m < 4; ++m) {
          const int row = row0 + ai * HALF + m * 16;
          f32x4 v0 = acc[ai][bj][m][0], v1 = acc[ai][bj][m][1];
          if (within >= 4) {
            const int t = row & (SEQ - 1);
            const float pos = (float)(within == 4 ? (t >> 6) : (t & 63));
#pragma unroll
            for (int j = 0; j < 4; ++j) { float s, c; sincos_rev(pos * fr_rev[j], s, c);
              const float x1 = v0[j], x2 = v1[j]; v0[j] = x1 * c - x2 * s; v1[j] = x2 * c + x1 * s; }
          }
          bf16_t* rowp = O + (size_t)row * 1536 + col0;
          u32x2 w0, w1; w0.x = pk_bf16(v0[0], v0[1]); w0.y = pk_bf16(v0[2], v0[3]); w1.x = pk_bf16(v1[0], v1[1]); w1.y = pk_bf16(v1[2], v1[3]);
          *(u32x2*)(rowp) = w0; *(u32x2*)(rowp + 16) = w1;
        }
    }
  }
};
template <bool XIN_F32>
struct EpiResid {
  static constexpr bool PERM = true;
  const void* xin; bf16_t* xout; const float* gate;
  __device__ __forceinline__ void operator()(const f32x4 (&acc)[2][2][4][2], const Unit& u, int wr, int wc, int fr, int fq) const {
    const int row0 = u.pm * BM + wr * 64 + fr, col0 = u.pn * BM + wc * 32 + 8 * fq;
    const float* gp = gate + (size_t)((u.pm * BM) / SEQ) * 6144 + col0;
    f32x4 gv[2][2];
#pragma unroll
    for (int bj = 0; bj < 2; ++bj)
#pragma unroll
      for (int n = 0; n < 2; ++n) gv[bj][n] = *(const f32x4*)(gp + bj * HALF + n * 4);
    f32x4 xa[2][2], xb[2][2];
#define EPR_LOAD(X, g) do { const size_t off_ = (size_t)(row0 + ((g) >> 2) * HALF + ((g) & 3) * 16) * DM + col0; \
      _Pragma("unroll") for (int bj = 0; bj < 2; ++bj) { \
        if (XIN_F32) { X[bj][0] = *(const f32x4*)((const float*)xin + off_ + bj * HALF); X[bj][1] = *(const f32x4*)((const float*)xin + off_ + bj * HALF + 4); } \
        else { const u32x4 t_ = *(const u32x4*)((const bf16_t*)xin + off_ + bj * HALF); X[bj][0] = (f32x4){bf_lo(t_.x), bf_hi(t_.x), bf_lo(t_.y), bf_hi(t_.y)}; X[bj][1] = (f32x4){bf_lo(t_.z), bf_hi(t_.z), bf_lo(t_.w), bf_hi(t_.w)}; } } } while (0)
#define EPR_STORE(X, g) do { const size_t off_ = (size_t)(row0 + ((g) >> 2) * HALF + ((g) & 3) * 16) * DM + col0; \
      _Pragma("unroll") for (int bj = 0; bj < 2; ++bj) { const f32x4 v0_ = X[bj][0] + gv[bj][0] * acc[(g) >> 2][bj][(g) & 3][0], v1_ = X[bj][1] + gv[bj][1] * acc[(g) >> 2][bj][(g) & 3][1]; \
        u32x4 w_; w_.x = pk_bf16(v0_[0], v0_[1]); w_.y = pk_bf16(v0_[2], v0_[3]); w_.z = pk_bf16(v1_[0], v1_[1]); w_.w = pk_bf16(v1_[2], v1_[3]); *(u32x4*)(xout + off_ + bj * HALF) = w_; } } while (0)
    EPR_LOAD(xa, 0); EPR_LOAD(xb, 1);
    EPR_STORE(xa, 0); EPR_LOAD(xa, 2); EPR_STORE(xb, 1); EPR_LOAD(xb, 3);
    EPR_STORE(xa, 2); EPR_LOAD(xa, 4); EPR_STORE(xb, 3); EPR_LOAD(xb, 5);
    EPR_STORE(xa, 4); EPR_LOAD(xa, 6); EPR_STORE(xb, 5); EPR_LOAD(xb, 7);
    EPR_STORE(xa, 6); EPR_STORE(xb, 7);
#undef EPR_LOAD
#undef EPR_STORE
  }
};
struct EpiSwiglu {
  static constexpr bool PERM = true;
  bf16_t* O; int ldc;
  __device__ __forceinline__ void operator()(const f32x4 (&acc)[2][2][4][2], const Unit& u, int wr, int wc, int fr, int fq) const {
    const int row0 = u.pm * BM + wr * 64 + fr, col0 = u.pn * HALF + wc * 32 + 8 * fq;
#pragma unroll
    for (int ai = 0; ai < 2; ++ai)
#pragma unroll
      for (int m = 0; m < 4; ++m) { float r[8];
#pragma unroll
        for (int n = 0; n < 2; ++n) { const f32x4 g = acc[ai][0][m][n], up = acc[ai][1][m][n];
#pragma unroll
          for (int j = 0; j < 4; ++j) r[4 * n + j] = g[j] * __builtin_amdgcn_rcpf(1.0f + __builtin_amdgcn_exp2f(-g[j] * 1.4426950408889634f)) * up[j]; }
        u32x4 w; w.x = pk_bf16(r[0], r[1]); w.y = pk_bf16(r[2], r[3]); w.z = pk_bf16(r[4], r[5]); w.w = pk_bf16(r[6], r[7]);
        *(u32x4*)(O + (size_t)(row0 + ai * HALF + m * 16) * ldc + col0) = w; }
  }
};
struct EpiConvIn {
  static constexpr bool PERM = true;
  bf16_t* CV; bf16_t* BG;
  __device__ __forceinline__ void operator()(const f32x4 (&acc)[2][2][4][2], const Unit& u, int wr, int wc, int fr, int fq) const {
    const int row0 = u.pm * BM + wr * 64 + fr;
#pragma unroll
    for (int ai = 0; ai < 2; ++ai)
#pragma unroll
      for (int m = 0; m < 4; ++m) { const size_t row = (size_t)(row0 + ai * HALF + m * 16);
        if (u.pn < 8) { const f32x4 r0 = acc[ai][0][m][0] * acc[ai][1][m][0], r1 = acc[ai][0][m][1] * acc[ai][1][m][1];
          u32x4 w; w.x = pk_bf16(r0[0], r0[1]); w.y = pk_bf16(r0[2], r0[3]); w.z = pk_bf16(r1[0], r1[1]); w.w = pk_bf16(r1[2], r1[3]);
          *(u32x4*)(CV + row * DM + u.pn * HALF + wc * 32 + 8 * fq) = w;
        } else {
#pragma unroll
          for (int bj = 0; bj < 2; ++bj) { const f32x4 a = acc[ai][bj][m][0], b = acc[ai][bj][m][1];
            u32x4 w; w.x = pk_bf16(a[0], a[1]); w.y = pk_bf16(a[2], a[3]); w.z = pk_bf16(b[0], b[1]); w.w = pk_bf16(b[2], b[3]);
            *(u32x4*)(BG + row * DM + (u.pn - 8) * BM + bj * HALF + wc * 32 + 8 * fq) = w; } } }
  }
};
}

namespace att {
constexpr int NW = 8, QBLK = 32, KVBLK = 64;
constexpr int LDQ = 1536, LDK = DQK, LDO = 1024;
constexpr float SCALE = 0.07216878364870322f;
constexpr float THR = 8.f;
constexpr int SHM_V = KVBLK * 128 * 2, SHM_K = KVBLK * DQK * 2;
constexpr int SHM_ATTN = 2 * SHM_V + 2 * SHM_K + NW * 64 * 4;
#define KSWZ(row, colB) ((row) * 384 + ((colB) ^ ((((row) >> 1) & 7) << 4)))
#define SBAR() __builtin_amdgcn_sched_barrier(0)
__device__ __forceinline__ int crow(int r, int hi) { return (r & 3) + 8 * (r >> 2) + 4 * hi; }
__device__ __forceinline__ unsigned cvtpk(float lo, float hi) { return pk_bf16(lo, hi); }

__device__ __forceinline__ void partialSM(f32x16& p0, f32x16& p1, float& m_reg, float& mn, float& alpha) {
  constexpr float C = SCALE * 1.4426950408889634f;
  float pmax = p0[0];
#pragma unroll
  for (int r = 1; r < 16; ++r) pmax = fmaxf(pmax, p0[r]);
#pragma unroll
  for (int r = 0; r < 16; ++r) pmax = fmaxf(pmax, p1[r]);
  { auto rr = __builtin_amdgcn_permlane32_swap(__float_as_uint(pmax), __float_as_uint(pmax), false, false);
    pmax = fmaxf(__uint_as_float(rr[0]), __uint_as_float(rr[1])); }
  if (__builtin_expect(__all(pmax - m_reg <= THR / SCALE), 1)) { mn = m_reg; alpha = 1.f; }
  else { mn = fmaxf(m_reg, pmax); alpha = __builtin_amdgcn_exp2f((m_reg - mn) * C); m_reg = mn; }
  float mnC = -mn * C;
#pragma unroll
  for (int r = 0; r < 16; ++r) p0[r] = fmaf(p0[r], C, mnC);
#pragma unroll
  for (int r = 0; r < 16; ++r) p1[r] = fmaf(p1[r], C, mnC);
#pragma unroll
  for (int r = 0; r < 16; ++r) p0[r] = __builtin_amdgcn_exp2f(p0[r]);
}
__device__ __forceinline__ void finishSM(f32x16& p0, f32x16& p1, float alpha, float& l_reg, bf16x8& pa0, bf16x8& pa1, bf16x8& pa2, bf16x8& pa3) {
#pragma unroll
  for (int r = 0; r < 16; ++r) p1[r] = __builtin_amdgcn_exp2f(p1[r]);
  float ps = 0;
#pragma unroll
  for (int r = 0; r < 16; ++r) ps += p0[r];
#pragma unroll
  for (int r = 0; r < 16; ++r) ps += p1[r];
  { auto rr = __builtin_amdgcn_permlane32_swap(__float_as_uint(ps), __float_as_uint(ps), false, false);
    ps = __uint_as_float(rr[0]) + __uint_as_float(rr[1]); }
  l_reg = l_reg * alpha + ps;
#define PK4(P, BASE, OUT) do { unsigned a0 = cvtpk(P[BASE + 0], P[BASE + 1]), a1 = cvtpk(P[BASE + 2], P[BASE + 3]);   \
    unsigned b0 = cvtpk(P[BASE + 4], P[BASE + 5]), b1 = cvtpk(P[BASE + 6], P[BASE + 7]);                              \
    auto r0 = __builtin_amdgcn_permlane32_swap(a0, b0, false, false); auto r1 = __builtin_amdgcn_permlane32_swap(a1, b1, false, false); \
    u32x4 w = {r0[0], r1[0], r0[1], r1[1]}; OUT = *reinterpret_cast<bf16x8*>(&w); } while (0)
  PK4(p0, 0, pa0); PK4(p0, 8, pa1); PK4(p1, 0, pa2); PK4(p1, 8, pa3);
#undef PK4
}
__device__ __forceinline__ void qkt(f32x16& p0, f32x16& p1, const char* Ks, const bf16x8* qr, int r32, int hi) {
  p0 = f32x16{}; p1 = f32x16{};
#pragma unroll
  for (int d0 = 0; d0 < 12; ++d0) { int cb = (d0 * 16 + hi * 8) * 2;
    bf16x8 b0 = *reinterpret_cast<const bf16x8*>(Ks + KSWZ(r32, cb));
    bf16x8 b1 = *reinterpret_cast<const bf16x8*>(Ks + KSWZ(32 + r32, cb));
    p0 = __builtin_amdgcn_mfma_f32_32x32x16_bf16(b0, qr[d0], p0, 0, 0, 0);
    p1 = __builtin_amdgcn_mfma_f32_32x32x16_bf16(b1, qr[d0], p1, 0, 0, 0);
    if ((d0 & 3) == 3 && d0 != 11) SBAR(); }
}
__device__ __forceinline__ int v_st(int k, int c) { const int kk = (k & ~0xC) | ((k & 4) << 1) | ((k & 8) >> 1); return ((kk >> 3) * 4 + (c >> 5)) * 512 + ((kk & 7) * 32 + (c & 31)) * 2; }
__device__ __forceinline__ int v_rd_base(int lane) { return ((lane & 3) << 3) | (((lane >> 2) & 3) << 6) | (((lane >> 4) & 1) << 5) | (((lane >> 5) & 1) << 8); }
constexpr int v_rd_off(int d0, int ks, int half) { return d0 * 512 + ks * 4096 + half * 2048; }
template <int OFF> __device__ __forceinline__ s16x4 tr_read(int vb) {
  s16x4 r; asm volatile("ds_read_b64_tr_b16 %0, %1 offset:%2" : "=&v"(r) : "v"(vb), "i"(OFF) : "memory"); return r;
}
template <int D0> __device__ __forceinline__ void pv_one(f32x16& od, int vb, bf16x8 pa0, bf16x8 pa1, bf16x8 pa2, bf16x8 pa3) {
  const s16x4 l0 = tr_read<v_rd_off(D0, 0, 0)>(vb), h0 = tr_read<v_rd_off(D0, 0, 1)>(vb), l1 = tr_read<v_rd_off(D0, 1, 0)>(vb), h1 = tr_read<v_rd_off(D0, 1, 1)>(vb);
  const s16x4 l2 = tr_read<v_rd_off(D0, 2, 0)>(vb), h2 = tr_read<v_rd_off(D0, 2, 1)>(vb), l3 = tr_read<v_rd_off(D0, 3, 0)>(vb), h3 = tr_read<v_rd_off(D0, 3, 1)>(vb);
  asm volatile("s_waitcnt lgkmcnt(0)" ::: "memory"); SBAR();
#define PK(L, H) (bf16x8){L[0], L[1], L[2], L[3], H[0], H[1], H[2], H[3]}
  od = __builtin_amdgcn_mfma_f32_32x32x16_bf16(pa0, PK(l0, h0), od, 0, 0, 0);
  od = __builtin_amdgcn_mfma_f32_32x32x16_bf16(pa1, PK(l1, h1), od, 0, 0, 0);
  od = __builtin_amdgcn_mfma_f32_32x32x16_bf16(pa2, PK(l2, h2), od, 0, 0, 0);
  od = __builtin_amdgcn_mfma_f32_32x32x16_bf16(pa3, PK(l3, h3), od, 0, 0, 0);
#undef PK
}
__device__ __forceinline__ void pv_d0(f32x16* o, int vb, bf16x8 pa0, bf16x8 pa1, bf16x8 pa2, bf16x8 pa3) {
  pv_one<0>(o[0], vb, pa0, pa1, pa2, pa3); pv_one<1>(o[1], vb, pa0, pa1, pa2, pa3); pv_one<2>(o[2], vb, pa0, pa1, pa2, pa3); pv_one<3>(o[3], vb, pa0, pa1, pa2, pa3);
}

constexpr int SLOT = SHM_K + SHM_V;
constexpr int NTILE = SKV / KVBLK;
static_assert(NTILE % 6 == 0, "tile loop is unrolled by 6");
constexpr int ATT_WS = 3 * SLOT;
__device__ __forceinline__ void attn_unit(int wsg, const bf16_t* __restrict__ Qb, const bf16_t* __restrict__ Kh, bf16_t* __restrict__ Ob, LAS unsigned char* ldsl) {
  const int tid = opaque_tid(wsg), wid = __builtin_amdgcn_readfirstlane(tid >> 6), lane = tid & 63, r32 = lane & 31, hi = lane >> 5;
  LAS float* ws = (LAS float*)(ldsl + ATT_WS) + wid * 64; LAS float* li_l = ws; LAS float* al_l = ws + 32;
  float m_reg = -1e30f, l_reg = 0; f32x16 o[4] = {}; bf16x8 qr[8];
  const bf16_t* Qw = Qb + (long)(wid * QBLK + r32) * LDQ + hi * 8;
#pragma unroll
  for (int d0 = 0; d0 < 8; ++d0) qr[d0] = *reinterpret_cast<const bf16x8*>(Qw + d0 * 16);
  LAS bf16x8* qlds = (LAS bf16x8*)(ldsl + ATT_WS + 2048 + wid * 4096) + lane;
#pragma unroll
  for (int i = 0; i < 4; ++i) qlds[i * 64] = *reinterpret_cast<const bf16x8*>(Qw + (8 + i) * 16);
  unsigned soff[5];
#pragma unroll
  for (int i = 0; i < 5; ++i) { const int ob = (wid * 5 + i) * 1024 + lane * 16;
    if (ob < SHM_K) { const int row = ob / 384, cph = ob % 384; soff[i] = (unsigned)(row * 384 + (cph ^ (((row >> 1) & 7) << 4))); }
    else { const int o2 = ob - SHM_K, st = o2 >> 9, wi = o2 & 511, kk = (st >> 2) * 8 + (wi >> 6), cc = (wi & 63) >> 1, cg = st & 3;
      const int k = (kk & ~0xC) | ((kk & 4) << 1) | ((kk & 8) >> 1); soff[i] = (unsigned)(k * 384 + (cg * 32 + cc) * 2); } }
  const int tsw = (hi * 16) ^ (((r32 >> 1) & 7) << 4);
  int kbs[4];
#pragma unroll
  for (int m = 0; m < 4; ++m) kbs[m] = r32 * 384 + ((m * 32) ^ tsw);
  const int vb0 = (int)(uintptr_t)(ldsl + SHM_K) + v_rd_base(lane);
#define ISSUE(SI, TI) do { const char* gb_ = (const char*)Kh + (size_t)(TI) * (KVBLK * 384); asm volatile("" : "+s"(gb_)); \
    _Pragma("unroll") for (int i_ = 0; i_ < 5; ++i_) __builtin_amdgcn_global_load_lds((const unsigned*)(gb_ + soff[i_]), (LAS unsigned*)(ldsl + (SI) * SLOT + (wid * 5 + i_) * 1024), 16, 0, 0); } while (0)
#define WAITBAR() asm volatile("s_waitcnt vmcnt(0) lgkmcnt(0)\n\ts_barrier" ::: "memory")
#define RESC(a) do { if (__any((a) < 1.f)) { if (hi == 0) al_l[r32] = (a); asm volatile("s_waitcnt lgkmcnt(0)" ::: "memory"); \
    _Pragma("unroll") for (int d = 0; d < 4; ++d) _Pragma("unroll") for (int r = 0; r < 16; ++r) o[d][r] *= al_l[crow(r, hi)]; } } while (0)
#define KLD(d0, SK, H) (*(const LAS bf16x8*)(ldsl + kbs[(d0) & 3] + ((SK) * SLOT + ((d0) >> 2) * 128 + (H) * (32 * 384))))
#define QKT(P0, P1, SK) do { P0 = f32x16{}; P1 = f32x16{}; \
    _Pragma("unroll") for (int d0 = 0; d0 < 12; ++d0) { \
      const bf16x8 b0_ = KLD(d0, SK, 0); const bf16x8 b1_ = KLD(d0, SK, 1); \
      bf16x8 qf_; if (d0 < 8) qf_ = qr[d0 < 8 ? d0 : 0]; else qf_ = qlds[(d0 - 8) * 64]; \
      P0 = __builtin_amdgcn_mfma_f32_32x32x16_bf16(b0_, qf_, P0, 0, 0, 0); \
      P1 = __builtin_amdgcn_mfma_f32_32x32x16_bf16(b1_, qf_, P1, 0, 0, 0); } } while (0)
#define QKT_SCHED() do { __builtin_amdgcn_sched_group_barrier(0x100, 2, 0); \
    _Pragma("unroll") for (int d0 = 0; d0 < 12; ++d0) { \
      __builtin_amdgcn_sched_group_barrier(0x008, 1, 0); __builtin_amdgcn_sched_group_barrier(0x400, 1, 0); __builtin_amdgcn_sched_group_barrier(0x002, 4, 0); \
      if (d0 < 7) __builtin_amdgcn_sched_group_barrier(0x100, 2, 0); else if (d0 < 11) __builtin_amdgcn_sched_group_barrier(0x100, 3, 0); \
      __builtin_amdgcn_sched_group_barrier(0x008, 1, 0); __builtin_amdgcn_sched_group_barrier(0x400, 1, 0); __builtin_amdgcn_sched_group_barrier(0x002, 4, 0); } } while (0)
#define PSM_A(P0, P1) do { pmax_ = P0[0]; _Pragma("unroll") for (int r = 1; r < 16; ++r) pmax_ = fmaxf(pmax_, P0[r]); _Pragma("unroll") for (int r = 0; r < 16; ++r) pmax_ = fmaxf(pmax_, P1[r]); } while (0)
#define PSM_B(P0, P1, MN, AL) do { constexpr float C_ = SCALE * 1.4426950408889634f; \
    { auto rr_ = __builtin_amdgcn_permlane32_swap(__float_as_uint(pmax_), __float_as_uint(pmax_), false, false); pmax_ = fmaxf(__uint_as_float(rr_[0]), __uint_as_float(rr_[1])); } \
    const bool keep_ = __all(pmax_ - m_reg <= THR / SCALE); const float mc_ = fmaxf(m_reg, pmax_); const float a2_ = __builtin_amdgcn_exp2f((m_reg - mc_) * C_); \
    MN = keep_ ? m_reg : mc_; AL = keep_ ? 1.f : a2_; m_reg = MN; mnC_ = -MN * C_; \
    _Pragma("unroll") for (int r = 0; r < 16; ++r) P0[r] = fmaf(P0[r], C_, mnC_); } while (0)
#define PSM_C(P0, P1) do { constexpr float C_ = SCALE * 1.4426950408889634f; \
    _Pragma("unroll") for (int r = 0; r < 16; ++r) P1[r] = fmaf(P1[r], C_, mnC_); \
    _Pragma("unroll") for (int r = 0; r < 4; ++r) P0[r] = __builtin_amdgcn_exp2f(P0[r]); } while (0)
#define PSM_D(P0) do { _Pragma("unroll") for (int r = 4; r < 16; ++r) P0[r] = __builtin_amdgcn_exp2f(P0[r]); } while (0)
#define HALF(PX0, PX1, MNX, ALX, PY0, PY1, ALY, SK, SV, SI, TI) do { \
    WAITBAR(); \
    if ((TI) < NTILE) ISSUE(SI, TI); \
    SBAR(); QKT(PX0, PX1, SK); \
    finishSM(PY0, PY1, ALY, l_reg, pa0, pa1, pa2, pa3); QKT_SCHED(); SBAR(); \
    { float pmax_, mnC_; const int vb_ = vb0 + (SV) * SLOT; \
      pv_one<0>(o[0], vb_, pa0, pa1, pa2, pa3); PSM_A(PX0, PX1); \
      pv_one<1>(o[1], vb_, pa0, pa1, pa2, pa3); PSM_B(PX0, PX1, MNX, ALX); \
      pv_one<2>(o[2], vb_, pa0, pa1, pa2, pa3); PSM_C(PX0, PX1); \
      pv_one<3>(o[3], vb_, pa0, pa1, pa2, pa3); PSM_D(PX0); asm volatile("" : "+v"(PX0), "+v"(PX1)); } \
    RESC(ALX); } while (0)
  f32x16 pA0, pA1, pB0, pB1; float mnA, mnB, alA, alB; bf16x8 pa0, pa1, pa2, pa3;
  ISSUE(0, 0); WAITBAR(); ISSUE(1, 1);
  QKT(pA0, pA1, 0); partialSM(pA0, pA1, m_reg, mnA, alA);
  for (int j = 1; j + 5 < NTILE; j += 6) {
    HALF(pB0, pB1, mnB, alB, pA0, pA1, alA, 1, 0, 2, j + 1);
    HALF(pA0, pA1, mnA, alA, pB0, pB1, alB, 2, 1, 0, j + 2);
    HALF(pB0, pB1, mnB, alB, pA0, pA1, alA, 0, 2, 1, j + 3);
    HALF(pA0, pA1, mnA, alA, pB0, pB1, alB, 1, 0, 2, j + 4);
    HALF(pB0, pB1, mnB, alB, pA0, pA1, alA, 2, 1, 0, j + 5);
    HALF(pA0, pA1, mnA, alA, pB0, pB1, alB, 0, 2, 1, j + 6);
  }
  HALF(pB0, pB1, mnB, alB, pA0, pA1, alA, 1, 0, 2, NTILE - 4);
  HALF(pA0, pA1, mnA, alA, pB0, pB1, alB, 2, 1, 0, NTILE - 3);
  HALF(pB0, pB1, mnB, alB, pA0, pA1, alA, 0, 2, 1, NTILE - 2);
  HALF(pA0, pA1, mnA, alA, pB0, pB1, alB, 1, 0, 2, NTILE - 1);
  HALF(pB0, pB1, mnB, alB, pA0, pA1, alA, 2, 1, 0, NTILE);
  finishSM(pB0, pB1, alB, l_reg, pa0, pa1, pa2, pa3); SBAR();
  pv_d0(o, vb0 + 2 * SLOT, pa0, pa1, pa2, pa3);
  if (hi == 0) li_l[r32] = l_reg; asm volatile("s_waitcnt lgkmcnt(0)" ::: "memory");
  bf16_t* Ow = Ob + (long)(wid * QBLK) * LDO;
#pragma unroll
  for (int r = 0; r < 16; ++r) { const int orow = crow(r, hi); const float rli = __builtin_amdgcn_rcpf(li_l[orow]);
#pragma unroll
    for (int d0 = 0; d0 < 4; ++d0) Ow[(long)orow * LDO + d0 * 32 + r32] = (bf16_t)(pk_bf16(o[d0][r] * rli, 0.f) & 0xffffu); }
#undef ISSUE
#undef WAITBAR
#undef RESC
#undef QKT
#undef PSM_A
#undef PSM_B
#undef PSM_C
#undef PSM_D
#undef QKT_SCHED
#undef KLD
#undef HALF
}
}

struct Params {
  const float* x; const float* c; const float* ctx; const float* c_ctx; const float* ada_w; const float* ada_b; const float* norm_mix; const float* norm_ffn;
  const float* w_dq; const float* q_norm; const float* w_uq; const float* w_dkv; const float* kv_norm; const float* w_ukv; const float* w_o;
  const float* conv_w_in; const float* conv_w; const float* conv_w_out; const float* w_gate; const float* w_up; const float* w_down; const float* final_norm;
  float* out; unsigned char* ws;
};

template <bool FINAL, bool SRC16>
__device__ __forceinline__ void norm_rows(int wsg, const float* src_lat, const float* src_ctx, const bf16_t* src16, int nrows, const float* w, const float* mod, int sh_off, int sc_off, bf16_t* H, float* outf) {
  const int tid_ = opaque_tid(wsg); const int lane = tid_ & 63, wv = blockIdx.x * 8 + (tid_ >> 6), nw = gridDim.x * 8;
  f32x4 wv4[4];
#pragma unroll
  for (int i = 0; i < 2; ++i) { wv4[2 * i] = *(const f32x4*)(w + i * 512 + lane * 8); wv4[2 * i + 1] = *(const f32x4*)(w + i * 512 + lane * 8 + 4); }
  for (int row = wv; row < nrows; row += nw) {
    f32x4 v[4]; float ss = 0.f;
    if (SRC16) { const bf16_t* xp = src16 + (size_t)row * DM;
#pragma unroll
      for (int i = 0; i < 2; ++i) { const u32x4 t = *(const u32x4*)(xp + i * 512 + lane * 8); v[2 * i] = (f32x4){bf_lo(t.x), bf_hi(t.x), bf_lo(t.y), bf_hi(t.y)}; v[2 * i + 1] = (f32x4){bf_lo(t.z), bf_hi(t.z), bf_lo(t.w), bf_hi(t.w)}; }
    } else { const float* xp = row < MLAT ? src_lat + (size_t)row * DM : src_ctx + (size_t)(row - MLAT) * DM;
#pragma unroll
      for (int i = 0; i < 2; ++i) { v[2 * i] = *(const f32x4*)(xp + i * 512 + lane * 8); v[2 * i + 1] = *(const f32x4*)(xp + i * 512 + lane * 8 + 4); } }
#pragma unroll
    for (int i = 0; i < 4; ++i) ss += v[i][0] * v[i][0] + v[i][1] * v[i][1] + v[i][2] * v[i][2] + v[i][3] * v[i][3];
    ss = wave_sum(ss);
    const float rstd = rsqrtf(ss * (1.0f / DM) + NORM_EPS);
    if (FINAL) {
#pragma unroll
      for (int i = 0; i < 2; ++i) { *(f32x4*)(outf + (size_t)row * DM + i * 512 + lane * 8) = v[2 * i] * rstd * wv4[2 * i]; *(f32x4*)(outf + (size_t)row * DM + i * 512 + lane * 8 + 4) = v[2 * i + 1] * rstd * wv4[2 * i + 1]; }
    } else {
      const int mr = row < MLAT ? row / SEQ : 4;
      const float* mp = mod + (size_t)mr * 6144;
#pragma unroll
      for (int i = 0; i < 2; ++i) { const int c = i * 512 + lane * 8;
        const f32x4 sh0 = *(const f32x4*)(mp + sh_off + c), sh1 = *(const f32x4*)(mp + sh_off + c + 4), sc0 = *(const f32x4*)(mp + sc_off + c), sc1 = *(const f32x4*)(mp + sc_off + c + 4);
        const f32x4 h0 = v[2 * i] * rstd * wv4[2 * i] * (1.0f + sc0) + sh0, h1 = v[2 * i + 1] * rstd * wv4[2 * i + 1] * (1.0f + sc1) + sh1;
        u32x4 o; o.x = pk_bf16(h0[0], h0[1]); o.y = pk_bf16(h0[2], h0[3]); o.z = pk_bf16(h1[0], h1[1]); o.w = pk_bf16(h1[2], h1[3]);
        *(u32x4*)(H + (size_t)row * DM + c) = o; }
    }
  }
}

typedef const __attribute__((address_space(4))) Params* ParamsK;
__device__ __forceinline__ ParamsK kparams() { auto kp = __builtin_amdgcn_kernarg_segment_ptr(); asm volatile("" : "+s"(kp)); return (ParamsK)kp; }
#define WSP(T, OFF) ((T*)(q->ws + (OFF)))

__device__ __forceinline__ void phase_adaln(int wsg, unsigned char* shm) {
  ParamsK q = kparams();
  const int tid = opaque_tid(wsg), lane = tid & 63, wid = tid >> 6;
  const int G = gridDim.x, bid = blockIdx.x;
  float* lds_f = (float*)shm;
  float* mod = WSP(float, WS_MOD);
  for (int it = bid; it < 2 * 96; it += G) {
    const int layer = it / 96, n0 = (it % 96) * 64;
    float* sv = lds_f;
    float* part = lds_f + 5 * 1024;
    const float* cp = q->c; const float* ccp = q->c_ctx;
    for (int e = tid; e < 5 * 1024; e += 512) { const int r = e >> 10, k = e & 1023; const float cv = r < 4 ? cp[r * DM + k] : ccp[k]; sv[e] = silu_f(cv); }
    __syncthreads();
    float a0 = 0.f, a1 = 0.f, a2 = 0.f, a3 = 0.f, a4 = 0.f;
    const float* wp = q->ada_w + (size_t)layer * DM * 6144 + n0 + lane;
    for (int k = wid * 128; k < wid * 128 + 128; ++k) { const float wv = wp[(size_t)k * 6144];
      a0 += sv[k] * wv; a1 += sv[1024 + k] * wv; a2 += sv[2048 + k] * wv; a3 += sv[3072 + k] * wv; a4 += sv[4096 + k] * wv; }
    part[(wid * 5 + 0) * 64 + lane] = a0; part[(wid * 5 + 1) * 64 + lane] = a1; part[(wid * 5 + 2) * 64 + lane] = a2; part[(wid * 5 + 3) * 64 + lane] = a3; part[(wid * 5 + 4) * 64 + lane] = a4;
    __syncthreads();
    if (tid < 320) { const int r = tid >> 6, l = tid & 63; float s = 0.f;
#pragma unroll
      for (int w8 = 0; w8 < 8; ++w8) s += part[(w8 * 5 + r) * 64 + l];
      mod[((size_t)layer * 5 + r) * 6144 + n0 + l] = s + q->ada_b[layer * 6144 + n0 + l]; }
    __syncthreads();
  }
}
__device__ __forceinline__ void phase_prologue(int wsg, unsigned char* shm) {
  ParamsK q = kparams();
  const int tid = opaque_tid(wsg);
  const int G = gridDim.x, bid = blockIdx.x;
  float* lds_f = (float*)shm;
  {
    constexpr int T_QKVA = 8 * 16, T_GU = 88 * 16, T_D = 16 * 44, T_IN = 48 * 16, T_OUT = 16 * 16;
    constexpr int T_TOTAL = T_QKVA + 2 * T_GU + 2 * T_D + T_IN + T_OUT;
    const int t = tid, chunk = (t & 15) >> 2, cc = (t & 3) * 4;
    struct TItem { const float* sp; int ld; bf16_t* dst; int Kdst; int n0, k0; };
    auto decode = [&](int it) -> TItem { TItem r; int i = it;
      if (i < T_QKVA) { const int tn = i / 16, tk = i % 16, n16 = tn * 64 + 16 * chunk; r.n0 = tn * 64; r.k0 = tk * 64; r.dst = WSP(bf16_t, WS_WQKVA); r.Kdst = DM;
        if (tn < 4) { r.sp = q->w_dq + n16; r.ld = 256; } else { r.sp = n16 < 448 ? q->w_dkv + (n16 - 256) : (const float*)nullptr; r.ld = 192; } return r; }
      i -= T_QKVA;
      for (int layer = 0; layer < 2; ++layer) {
        if (i < T_GU) { const int tn = i / 16, tk = i % 16, n16 = tn * 64 + 16 * chunk; r.n0 = tn * 64; r.k0 = tk * 64; r.dst = WSP(bf16_t, layer ? WS_WGU1 : WS_WGU0); r.Kdst = DM; r.ld = DFF;
          r.sp = ((n16 & 128) ? q->w_up : q->w_gate) + (size_t)layer * DM * DFF + (n16 >> 8) * 128 + (n16 & 127); return r; }
        i -= T_GU;
        if (i < T_D) { const int tn = i / 44, tk = i % 44, n16 = tn * 64 + 16 * chunk; r.n0 = tn * 64; r.k0 = tk * 64; r.dst = WSP(bf16_t, layer ? WS_WD1 : WS_WD0); r.Kdst = DFF; r.ld = DM;
          r.sp = q->w_down + (size_t)layer * DFF * DM + n16; return r; }
        i -= T_D;
      }
      if (i < T_IN) { const int tn = i / 16, tk = i % 16, n16 = tn * 64 + 16 * chunk; r.n0 = tn * 64; r.k0 = tk * 64; r.dst = WSP(bf16_t, WS_WIN); r.Kdst = DM; r.ld = 3 * DM;
        if (n16 < 2048) r.sp = q->conv_w_in + ((n16 & 128) ? 2048 : 1024) + (n16 >> 8) * 128 + (n16 & 127); else r.sp = q->conv_w_in + (n16 - 2048); return r; }
      i -= T_IN;
      { const int tn = i / 16, tk = i % 16, n16 = tn * 64 + 16 * chunk; r.n0 = tn * 64; r.k0 = tk * 64; r.dst = WSP(bf16_t, WS_WOUT); r.Kdst = DM; r.ld = DM; r.sp = q->conv_w_out + n16; return r; }
    };
    auto load2 = [&](const TItem& I, f32x4& v0, f32x4& v1) { v0 = (f32x4){0.f, 0.f, 0.f, 0.f}; v1 = v0;
      if (I.sp) { v0 = *(const f32x4*)(I.sp + (size_t)(I.k0 + (t >> 4)) * I.ld + cc); v1 = *(const f32x4*)(I.sp + (size_t)(I.k0 + (t >> 4) + 32) * I.ld + cc); } };
    int it = bid;
    if (it < T_TOTAL) {
      TItem cur = decode(it); f32x4 v0, v1; load2(cur, v0, v1);
      for (;;) {
        const int nit = it + G; const bool has = nit < T_TOTAL; TItem nxt = cur; f32x4 n0v = v0, n1v = v1;
        if (has) { nxt = decode(nit); load2(nxt, n0v, n1v); }
        { float* lp = lds_f + (t >> 4) * 65 + chunk * 16 + cc; lp[0] = v0[0]; lp[1] = v0[1]; lp[2] = v0[2]; lp[3] = v0[3];
          lp += 32 * 65; lp[0] = v1[0]; lp[1] = v1[1]; lp[2] = v1[2]; lp[3] = v1[3]; }
        __syncthreads();
        { const int n = t >> 3, kk = (t & 7) * 8; float a[8];
#pragma unroll
          for (int j = 0; j < 8; ++j) a[j] = lds_f[(kk + j) * 65 + n];
          u32x4 w; w.x = pk_bf16(a[0], a[1]); w.y = pk_bf16(a[2], a[3]); w.z = pk_bf16(a[4], a[5]); w.w = pk_bf16(a[6], a[7]);
          *(u32x4*)(cur.dst + (size_t)(cur.n0 + n) * cur.Kdst + cur.k0 + kk) = w; }
        __syncthreads();
        if (!has) break;
        cur = nxt; v0 = n0v; v1 = n1v; it = nit;
      }
    }
  }
  const int gt = bid * 512 + tid, nthr = G * 512;
  { const float* w_ukv = q->w_ukv; const float* w_uq = q->w_uq; bf16_t* Wuq = WSP(bf16_t, WS_WUQ);
  for (int idx = gt; idx < 1536 * 32; idx += nthr) {
    const int n = idx >> 5, jg = (idx & 31) * 8, h = n / 192, c = n % 192; float a[8];
#pragma unroll
    for (int i = 0; i < 8; ++i) a[i] = 0.f;
    if (c < 128) { const float* kr = w_ukv + (size_t)c * 2048 + h * 256;
      for (int d = 0; d < 128; d += 4) { const f32x4 kv = *(const f32x4*)(kr + d);
#pragma unroll
        for (int i = 0; i < 8; ++i) { const f32x4 qv = *(const f32x4*)(w_uq + (size_t)(jg + i) * 1536 + h * 192 + d); a[i] += qv[0] * kv[0] + qv[1] * kv[1] + qv[2] * kv[2] + qv[3] * kv[3]; } }
    } else {
#pragma unroll
      for (int i = 0; i < 8; ++i) a[i] = w_uq[(size_t)(jg + i) * 1536 + n];
    }
    u32x4 w; w.x = pk_bf16(a[0], a[1]); w.y = pk_bf16(a[2], a[3]); w.z = pk_bf16(a[4], a[5]); w.w = pk_bf16(a[6], a[7]);
    *(u32x4*)(Wuq + (size_t)n * 256 + jg) = w;
  } }
  { const float* w_ukv = q->w_ukv; const float* w_o = q->w_o; bf16_t* Wo = WSP(bf16_t, WS_WO);
  for (int idx = gt; idx < 1024 * 128; idx += nthr) {
    const int n = idx & 1023, kg = __builtin_amdgcn_readfirstlane(idx >> 10), h = kg >> 4, c0 = (kg & 15) * 8; float a[8];
#pragma unroll
    for (int i = 0; i < 8; ++i) a[i] = 0.f;
    const float* wop = w_o + (size_t)(h * 128) * DM + n; const float* vr = w_ukv + (size_t)c0 * 2048 + h * 256 + 128;
    for (int d = 0; d < 128; ++d) { const float wv = wop[(size_t)d * DM];
#pragma unroll
      for (int i = 0; i < 8; ++i) a[i] += vr[(size_t)i * 2048 + d] * wv; }
    u32x4 w; w.x = pk_bf16(a[0], a[1]); w.y = pk_bf16(a[2], a[3]); w.z = pk_bf16(a[4], a[5]); w.w = pk_bf16(a[6], a[7]);
    *(u32x4*)(Wo + (size_t)n * DM + h * 128 + c0) = w;
  } }
}

__device__ __forceinline__ void phase_qkv_post(int wsg) {
  ParamsK q = kparams();
  const int tid = opaque_tid(wsg), lane = tid & 63, wid = tid >> 6;
  const int wv = blockIdx.x * 8 + wid, nw = gridDim.x * 8;
  const bf16_t* QKVA = WSP(bf16_t, WS_QKVA); bf16_t* QAN = WSP(bf16_t, WS_QAN); bf16_t* KV = WSP(bf16_t, WS_KV);
  const f32x4 qn = *(const f32x4*)(q->q_norm + lane * 4);
  const float kn0 = q->kv_norm[lane * 2], kn1 = q->kv_norm[lane * 2 + 1];
  const float frev = rope_freq_rev(lane & 15);
  for (int row = wv; row < MALL; row += nw) {
    const bf16_t* rp = QKVA + (size_t)row * 512;
    const u32x2 qa = *(const u32x2*)(rp + lane * 4); const unsigned ka = *(const unsigned*)(rp + 256 + lane * 2); const float kr = bf_lo((unsigned)rp[384 + lane]);
    const float q0 = bf_lo(qa.x), q1 = bf_hi(qa.x), q2 = bf_lo(qa.y), q3 = bf_hi(qa.y), k0 = bf_lo(ka), k1 = bf_hi(ka);
    const float qss = wave_sum(q0 * q0 + q1 * q1 + q2 * q2 + q3 * q3), kss = wave_sum(k0 * k0 + k1 * k1);
    const float qr = rsqrtf(qss * (1.0f / 256.0f) + NORM_EPS), krs = rsqrtf(kss * (1.0f / 128.0f) + NORM_EPS);
    size_t kvrow; float kro = kr;
    if (row < MLAT) { const int b = row / SEQ, t = row % SEQ; kvrow = (size_t)b * SKV + CTX + t;
      u32x2 o; o.x = pk_bf16(q0 * qr * qn[0], q1 * qr * qn[1]); o.y = pk_bf16(q2 * qr * qn[2], q3 * qr * qn[3]);
      *(u32x2*)(QAN + (size_t)row * 256 + lane * 4) = o;
      const float pos = (float)(lane < 32 ? (t >> 6) : (t & 63)); float s, c; sincos_rev(pos * frev, s, c);
      const float xp = __shfl_xor(kr, 16);
      kro = (lane & 16) ? kr * c + xp * s : kr * c - xp * s;
    } else { const int r2 = row - MLAT; kvrow = (size_t)(r2 / CTX) * SKV + (r2 % CTX); }
    bf16_t* kp = KV + kvrow * DQK;
    *(unsigned*)(kp + lane * 2) = pk_bf16(k0 * krs * kn0, k1 * krs * kn1);
    kp[128 + lane] = (bf16_t)(pk_bf16(kro, 0.f) & 0xffffu);
  }
}

__device__ __forceinline__ void phase_attn(int wsg, unsigned char* shm) {
  ParamsK q = kparams();
  const bf16_t* Qb = WSP(bf16_t, WS_Q); const bf16_t* KV = WSP(bf16_t, WS_KV); bf16_t* Ob = WSP(bf16_t, WS_O);
  for (int u = blockIdx.x; u < NB * NH * (SEQ / 256); u += gridDim.x) {
    const int w = u & 255, r = u >> 8, xcd = w & 7, slot = w >> 3;
    const int b = xcd >> 1, idx = (xcd & 1) * 128 + r * 32 + slot, h = idx >> 5, qb = idx & 31;
    __syncthreads();
    att::attn_unit(wsg, Qb + ((size_t)(b * SEQ + qb * 256) * 1536 + h * DQK), KV + (size_t)b * SKV * DQK, Ob + ((size_t)(b * SEQ + qb * 256) * DM + h * 128), (LAS unsigned char*)shm);
  }
}

__device__ __forceinline__ void phase_conv(int wsg) {
  ParamsK q = kparams();
  const int tid = opaque_tid(wsg);
  const bf16_t* CV = WSP(bf16_t, WS_CV); const bf16_t* BG = WSP(bf16_t, WS_BG); bf16_t* Z = WSP(bf16_t, WS_Z);
  const float* cw = q->conv_w;
  const size_t nitem = (size_t)MLAT * DM / 8;
  for (size_t it = (size_t)blockIdx.x * 512 + tid; it < nitem; it += (size_t)gridDim.x * 512) {
    const int row = (int)(it >> 7), d0 = (int)(it & 127) * 8, t = row & (SEQ - 1);
    const u32x4 cur = *(const u32x4*)(CV + (size_t)row * DM + d0);
    u32x4 prv = (u32x4){0u, 0u, 0u, 0u}, nxt = (u32x4){0u, 0u, 0u, 0u};
    if (t > 0) prv = *(const u32x4*)(CV + (size_t)(row - 1) * DM + d0);
    if (t < SEQ - 1) nxt = *(const u32x4*)(CV + (size_t)(row + 1) * DM + d0);
    const u32x4 bg = *(const u32x4*)(BG + (size_t)row * DM + d0);
    const float* w0 = cw + d0; const float* w1 = cw + DM + d0; const float* w2 = cw + 2 * DM + d0;
    u32x4 o;
#pragma unroll
    for (int k = 0; k < 4; ++k) {
      const float ul = w0[2 * k] * bf_lo(prv[k]) + w1[2 * k] * bf_lo(cur[k]) + w2[2 * k] * bf_lo(nxt[k]);
      const float uh = w0[2 * k + 1] * bf_hi(prv[k]) + w1[2 * k + 1] * bf_hi(cur[k]) + w2[2 * k + 1] * bf_hi(nxt[k]);
      o[k] = pk_bf16(bf_lo(bg[k]) * ul, bf_hi(bg[k]) * uh); }
    *(u32x4*)(Z + (size_t)row * DM + d0) = o;
  }
}

#define GEMM_SETUP(M_, N_) ParamsK q = kparams(); pg8::StaticOrder S; S.init((M_), (N_), gridDim.x, blockIdx.x); LAS unsigned char* ldsl = (LAS unsigned char*)shm
__device__ __forceinline__ void phase_gemm_qkva(int wsg, unsigned char* shm) { GEMM_SETUP(MALL, 512);
  pg8::Gemm g{WSP(bf16_t, WS_H), WSP(bf16_t, WS_WQKVA), MALL, 512, DM}; pg8::EpiBf16 E{WSP(bf16_t, WS_QKVA), 512}; pg8::gemm_phase<decltype(E), true, true>(wsg, ldsl, g, S, E); }
__device__ __forceinline__ void phase_gemm_uq(int wsg, unsigned char* shm) { GEMM_SETUP(MLAT, 1536);
  pg8::Gemm g{WSP(bf16_t, WS_QAN), WSP(bf16_t, WS_WUQ), MLAT, 1536, 256}; pg8::EpiQRope E{WSP(bf16_t, WS_Q)}; pg8::gemm_phase(wsg, ldsl, g, S, E); }
__device__ __forceinline__ void phase_gemm_mixout0(int wsg, unsigned char* shm) { GEMM_SETUP(MLAT, DM);
  pg8::Gemm g{WSP(bf16_t, WS_O), WSP(bf16_t, WS_WO), MLAT, DM, DM};
  pg8::EpiResid<true> E{q->x, WSP(bf16_t, WS_X16), WSP(float, WS_MOD) + 2048}; pg8::gemm_phase<decltype(E), true, true>(wsg, ldsl, g, S, E); }
__device__ __forceinline__ void phase_gemm_mixout1(int wsg, unsigned char* shm) { GEMM_SETUP(MLAT, DM);
  pg8::Gemm g{WSP(bf16_t, WS_Z), WSP(bf16_t, WS_WOUT), MLAT, DM, DM};
  pg8::EpiResid<false> E{WSP(bf16_t, WS_X16), WSP(bf16_t, WS_X16), WSP(float, WS_MOD) + (size_t)5 * 6144 + 2048}; pg8::gemm_phase<decltype(E), true, true>(wsg, ldsl, g, S, E); }
__device__ __forceinline__ void phase_gemm_convin(int wsg, unsigned char* shm) { GEMM_SETUP(MLAT, 3 * DM);
  pg8::Gemm g{WSP(bf16_t, WS_H), WSP(bf16_t, WS_WIN), MLAT, 3 * DM, DM}; pg8::EpiConvIn E{WSP(bf16_t, WS_CV), WSP(bf16_t, WS_BG)}; pg8::gemm_phase<decltype(E), true, true>(wsg, ldsl, g, S, E); }
__device__ __forceinline__ void phase_gemm_gu(int wsg, unsigned char* shm, int layer) { GEMM_SETUP(MLAT, 2 * DFF);
  pg8::Gemm g{WSP(bf16_t, WS_H), WSP(bf16_t, layer ? WS_WGU1 : WS_WGU0), MLAT, 2 * DFF, DM}; pg8::EpiSwiglu E{WSP(bf16_t, WS_G), DFF}; pg8::gemm_phase<decltype(E), true, true>(wsg, ldsl, g, S, E); }
__device__ __forceinline__ void phase_gemm_down(int wsg, unsigned char* shm, int layer) { GEMM_SETUP(MLAT, DM);
  pg8::Gemm g{WSP(bf16_t, WS_G), WSP(bf16_t, layer ? WS_WD1 : WS_WD0), MLAT, DM, DFF};
  pg8::EpiResid<false> E{WSP(bf16_t, WS_X16), WSP(bf16_t, WS_X16), WSP(float, WS_MOD) + (size_t)layer * 5 * 6144 + 5120}; pg8::gemm_phase<decltype(E), true, true>(wsg, ldsl, g, S, E); }

#define XB_TMO      128
#define XB_XCNT(j)  (256  + 64 * (j))
#define XB_XSUB(j)  (1280 + 64 * (j))
#define XB_XGEN(j)  (2304 + 64 * (j))
#define XB_TOP      3328
#define XB_TOPGEN   3392
#define XB_SPIN_CAP (1u << 20)
constexpr int LDS_XB = LDS_BYTES - 16;
__device__ __forceinline__ unsigned xb_ld(unsigned* p)              { return __hip_atomic_load(p, __ATOMIC_RELAXED, __HIP_MEMORY_SCOPE_AGENT); }
__device__ __forceinline__ unsigned xb_add(unsigned* p, unsigned v) { return __hip_atomic_fetch_add(p, v, __ATOMIC_RELAXED, __HIP_MEMORY_SCOPE_AGENT); }
__device__ __forceinline__ unsigned xb_xcc_id() { return (unsigned)__builtin_amdgcn_s_getreg((3 << 11) | 20) & 0xFu; }
#define XB_SPIN(cond, bar) do { unsigned _sp = 0; while (cond) { __builtin_amdgcn_s_sleep(1); \
    if ((++_sp & 255u) == 0u) { if (xb_ld(&(bar)[XB_TMO])) break; if (_sp > XB_SPIN_CAP) { atomicAdd(&(bar)[XB_TMO], 1u); break; } } } } while (0)
__device__ __forceinline__ void xcd_barrier_complete(unsigned* bar, unsigned x, unsigned& nloc, unsigned& nx) {
  const unsigned G = gridDim.x;
  unsigned sum, cnt, mine, sp = 0u;
  for (;;) {
    sum = 0u; cnt = 0u; mine = 0u;
#pragma unroll
    for (unsigned j = 0; j < 16; ++j) { const unsigned c = xb_ld(&bar[XB_XCNT(j)]); sum += c; cnt += (c > 0u) ? 1u : 0u; mine = (j == x) ? c : mine; }
    if (sum == G) break;
    __builtin_amdgcn_s_sleep(1);
    if ((++sp & 255u) == 0u) { if (xb_ld(&bar[XB_TMO])) break; if (sp > XB_SPIN_CAP) { atomicAdd(&bar[XB_TMO], 1u); break; } }
  }
  nloc = mine > 0u ? mine : 1u; nx = cnt > 0u ? cnt : 1u;
}
__device__ __forceinline__ void grid_bar_post(int wsg, unsigned char* shm) {
  ParamsK q = kparams(); unsigned* bar = (unsigned*)q->ws; const unsigned x = xb_xcc_id();
  if (opaque_tid(wsg) == 0) { volatile LAS unsigned* st = (volatile LAS unsigned*)((LAS unsigned char*)shm + LDS_XB); st[0] = 0u; st[1] = 0u;
    (void)xb_add(&bar[XB_XCNT(x)], 1u); }
  __syncthreads();
}
__device__ __forceinline__ void grid_bar(int wsg, unsigned char* shm) {
  asm volatile("s_waitcnt vmcnt(0)" ::: "memory");
  __syncthreads();
  ParamsK q = kparams(); unsigned* bar = (unsigned*)q->ws; const unsigned x = xb_xcc_id();
  if (opaque_tid(wsg) == 0) {
    volatile LAS unsigned* st = (volatile LAS unsigned*)((LAS unsigned char*)shm + LDS_XB);
    __builtin_amdgcn_s_waitcnt(0);
    unsigned nloc = st[0], nx = st[1];
    if (nloc == 0u) { xcd_barrier_complete(bar, x, nloc, nx); st[0] = nloc; st[1] = nx; }
    const unsigned old = xb_add(&bar[XB_XSUB(x)], 1u);
    const unsigned gen = old / nloc;
    if (old + 1u == (gen + 1u) * nloc) {
      __builtin_amdgcn_fence(__ATOMIC_RELEASE, "agent");
      asm volatile("s_waitcnt vmcnt(0)" ::: "memory");
      const unsigned og = xb_add(&bar[XB_TOP], 1u);
      const unsigned tg = og / nx;
      if (og + 1u == (tg + 1u) * nx) xb_add(&bar[XB_TOPGEN], 1u);
      else XB_SPIN(xb_ld(&bar[XB_TOPGEN]) == tg, bar);
      __builtin_amdgcn_fence(__ATOMIC_ACQUIRE, "agent");
      xb_add(&bar[XB_XGEN(x)], 1u);
      asm volatile("s_waitcnt vmcnt(0)" ::: "memory");
    } else {
      XB_SPIN(xb_ld(&bar[XB_XGEN(x)]) == gen, bar);
      __builtin_amdgcn_fence(__ATOMIC_ACQUIRE, "agent");
      asm volatile("s_waitcnt vmcnt(0)" ::: "memory");
    }
  }
  __syncthreads();
}


__device__ __forceinline__ void phase_norm_mix0(int wsg) { ParamsK q = kparams();
  norm_rows<false, false>(wsg, q->x, q->ctx, nullptr, MALL, q->norm_mix, WSP(float, WS_MOD), 0, 1024, WSP(bf16_t, WS_H), nullptr); }
__device__ __forceinline__ void phase_norm_mix1(int wsg) { ParamsK q = kparams();
  norm_rows<false, true>(wsg, nullptr, nullptr, WSP(bf16_t, WS_X16), MLAT, q->norm_mix + DM, WSP(float, WS_MOD) + (size_t)5 * 6144, 0, 1024, WSP(bf16_t, WS_H), nullptr); }
template <int LAYER> __device__ __forceinline__ void phase_norm_ffn(int wsg) { ParamsK q = kparams();
  norm_rows<false, true>(wsg, nullptr, nullptr, WSP(bf16_t, WS_X16), MLAT, q->norm_ffn + LAYER * DM, WSP(float, WS_MOD) + (size_t)LAYER * 5 * 6144, 3072, 4096, WSP(bf16_t, WS_H), nullptr); }

__global__ void __launch_bounds__(512, 2) mk_fwd(Params p) {
  extern __shared__ __attribute__((aligned(16))) unsigned char shm[];
  cg::grid_group grid = cg::this_grid();
  const int wsg = __builtin_amdgcn_readfirstlane((int)(threadIdx.x >> 6));
  grid_bar_post(wsg, shm);
  phase_adaln(wsg, shm);
  grid.sync();
  phase_norm_mix0(wsg); phase_prologue(wsg, shm); grid_bar(wsg, shm);
  phase_gemm_qkva(wsg, shm); grid_bar(wsg, shm);
  phase_qkv_post(wsg); grid_bar(wsg, shm);
  phase_gemm_uq(wsg, shm); grid_bar(wsg, shm);
  phase_attn(wsg, shm); grid_bar(wsg, shm);
  phase_gemm_mixout0(wsg, shm); grid_bar(wsg, shm);
  phase_norm_ffn<0>(wsg); grid_bar(wsg, shm);
  phase_gemm_gu(wsg, shm, 0); grid_bar(wsg, shm);
  phase_gemm_down(wsg, shm, 0); grid_bar(wsg, shm);
  phase_norm_mix1(wsg); grid_bar(wsg, shm);
  phase_gemm_convin(wsg, shm); grid_bar(wsg, shm);
  phase_conv(wsg); grid_bar(wsg, shm);
  phase_gemm_mixout1(wsg, shm); grid_bar(wsg, shm);
  phase_norm_ffn<1>(wsg); grid_bar(wsg, shm);
  phase_gemm_gu(wsg, shm, 1); grid_bar(wsg, shm);
  phase_gemm_down(wsg, shm, 1); grid_bar(wsg, shm);
  { ParamsK q = kparams(); norm_rows<true, true>(wsg, nullptr, nullptr, WSP(bf16_t, WS_X16), MLAT, q->final_norm, nullptr, 0, 0, nullptr, q->out); }
}

extern "C" void kernel_launch(void* const* d_in, const int* in_sizes, int n_in, void* d_out, int out_size, void* d_ws, size_t ws_size, hipStream_t stream) {
  static int grid_blocks = 0;
  if (!grid_blocks) {
    if (ws_size < WS_END) { fprintf(stderr, "kernel_launch: ws too small %zu < %zu\n", ws_size, (size_t)WS_END); return; }
    if (hipFuncSetAttribute((const void*)mk_fwd, hipFuncAttributeMaxDynamicSharedMemorySize, LDS_BYTES) != hipSuccess) { fprintf(stderr, "kernel_launch: set LDS attr failed\n"); return; }
    int dev = 0, cus = 0, per_cu = 0;
    (void)hipGetDevice(&dev);
    (void)hipDeviceGetAttribute(&cus, hipDeviceAttributeMultiprocessorCount, dev);
    (void)hipOccupancyMaxActiveBlocksPerMultiprocessor(&per_cu, mk_fwd, 512, LDS_BYTES);
    if (per_cu < 1) { fprintf(stderr, "kernel_launch: occupancy 0\n"); return; }
    grid_blocks = cus;
  }
  Params p{};
  p.x = (const float*)d_in[0]; p.c = (const float*)d_in[1]; p.ctx = (const float*)d_in[2]; p.c_ctx = (const float*)d_in[3];
  p.ada_w = (const float*)d_in[4]; p.ada_b = (const float*)d_in[5]; p.norm_mix = (const float*)d_in[6]; p.norm_ffn = (const float*)d_in[7];
  p.w_dq = (const float*)d_in[8]; p.q_norm = (const float*)d_in[9]; p.w_uq = (const float*)d_in[10]; p.w_dkv = (const float*)d_in[11];
  p.kv_norm = (const float*)d_in[12]; p.w_ukv = (const float*)d_in[13]; p.w_o = (const float*)d_in[14];
  p.conv_w_in = (const float*)d_in[15]; p.conv_w = (const float*)d_in[16]; p.conv_w_out = (const float*)d_in[17];
  p.w_gate = (const float*)d_in[18]; p.w_up = (const float*)d_in[19]; p.w_down = (const float*)d_in[20]; p.final_norm = (const float*)d_in[21];
  p.out = (float*)d_out; p.ws = (unsigned char*)d_ws;
  void* args[] = {&p};
  (void)hipMemsetAsync(d_ws, 0, 16384, stream);
  hipError_t e = hipLaunchCooperativeKernel((void*)mk_fwd, dim3(grid_blocks), dim3(512), args, LDS_BYTES, stream);
  if (e != hipSuccess) fprintf(stderr, "cooperative launch failed: %s (grid %d)\n", hipGetErrorString(e), grid_blocks);
}
```
